# Optimizing an MI355X kernel written in HIP

```python
import jax, jax.numpy as jnp
from jax import lax
import numpy as np

D_MODEL = 1024
BATCH = 16
SEQ = 2048
DEPTH = 2

CHUNK = 64
M_HEADS = 4
M_HEAD_DIM = 256
M_WIDTH = M_HEADS * M_HEAD_DIM
M_CONV = 4
A_HEADS = 16
A_KV_HEADS = 4
A_HEAD_DIM = 64
A_Q_WIDTH = A_HEADS * A_HEAD_DIM
A_KV_WIDTH = A_KV_HEADS * A_HEAD_DIM
WINDOW = 128
A_PREV_CHUNKS = -(-(WINDOW - 1) // CHUNK)
ROPE_THETA = 10000.0
D_FF = 2816
N_IN = 3 * M_WIDTH + 2 * M_HEADS + A_Q_WIDTH + 2 * A_KV_WIDTH
EPS = 1e-6

kernel_name = 'hybrid_mlstm_swa_macaron_adaln'


def rms_norm(x, w):
    xf = x.astype(jnp.float32)
    y = xf * lax.rsqrt(jnp.mean(xf * xf, axis=-1, keepdims=True) + EPS)
    return (y * w.astype(jnp.float32)).astype(x.dtype)


def modulate(x, norm_w, shift, scale):
    return rms_norm(x, norm_w) * (1 + scale) + shift


def swiglu(h, w_in, w_out):
    a, g = jnp.split(h @ w_in, 2, axis=-1)
    return (jax.nn.silu(a) * g) @ w_out


def rope(x, pos):
    d = x.shape[-1]
    inv_freq = ROPE_THETA ** (-jnp.arange(0, d, 2, dtype=jnp.float32) / d)
    ang = pos.astype(jnp.float32)[..., None] * inv_freq
    cos, sin = jnp.cos(ang)[:, :, None, :], jnp.sin(ang)[:, :, None, :]
    xf = x.astype(jnp.float32)
    x1, x2 = xf[..., : d // 2], xf[..., d // 2:]
    return jnp.concatenate([x1 * cos - x2 * sin, x2 * cos + x1 * sin], axis=-1).astype(x.dtype)


def _mlstm_chunk(carry, xs):
    C, n, m = carry
    q, k, v, li, lf = xs
    L = q.shape[2]
    b = jnp.cumsum(lf, axis=-1)
    causal = jnp.arange(L)[:, None] >= jnp.arange(L)[None, :]
    d = jnp.where(causal, b[..., :, None] - b[..., None, :] + li[..., None, :], -jnp.inf)
    a = b + m[..., None]
    m_t = jnp.maximum(a, jnp.max(d, axis=-1))
    w_intra = jnp.exp(d - m_t[..., None])
    w_inter = jnp.exp(a - m_t)
    s = jnp.einsum('bhtd,bhsd->bhts', q, k) * w_intra
    num = jnp.einsum('bhts,bhsv->bhtv', s, v) + w_inter[..., None] * jnp.einsum('bhtd,bhdv->bhtv', q, C)
    den = jnp.sum(s, axis=-1) + w_inter * jnp.einsum('bhtd,bhd->bht', q, n)
    h = num / jnp.maximum(jnp.abs(den), jnp.exp(-m_t))[..., None]
    g = b[..., -1:] - b + li
    a_end = b[..., -1] + m
    m_new = jnp.maximum(a_end, jnp.max(g, axis=-1))
    wg = jnp.exp(g - m_new[..., None])
    decay = jnp.exp(a_end - m_new)
    kw = k * wg[..., None]
    C_new = decay[..., None, None] * C + jnp.einsum('bhsd,bhsv->bhdv', kw, v)
    n_new = decay[..., None] * n + jnp.sum(kw, axis=2)
    return (C_new, n_new, m_new), h


def mlstm_branch(u, v, o_pre, i_pre, f_pre, conv_w, conv_b, wq, wk, out_norm, skip):
    B, S, _ = u.shape
    nc = S // CHUNK
    uc = lax.conv_general_dilated(u, conv_w[:, None, :], window_strides=(1,),
                                  padding=[(M_CONV - 1, 0)],
                                  dimension_numbers=('NWC', 'WIO', 'NWC'),
                                  feature_group_count=M_WIDTH)
    ua = jax.nn.silu(uc + conv_b)
    uh = ua.reshape(B, S, M_HEADS, M_HEAD_DIM)
    q = jnp.einsum('bshd,hde->bshe', uh, wq)
    k = jnp.einsum('bshd,hde->bshe', uh, wk) * (M_HEAD_DIM ** -0.5)
    vh = v.reshape(B, S, M_HEADS, M_HEAD_DIM)

    def chunks4(t):
        return t.astype(jnp.float32).reshape(B, nc, CHUNK, M_HEADS, -1).transpose(1, 0, 3, 2, 4)

    def chunks3(t):
        return t.astype(jnp.float32).reshape(B, nc, CHUNK, M_HEADS).transpose(1, 0, 3, 2)

    li = chunks3(i_pre)
    lf = chunks3(jax.nn.log_sigmoid(f_pre.astype(jnp.float32)))
    carry0 = (jnp.zeros((B, M_HEADS, M_HEAD_DIM, M_HEAD_DIM), jnp.float32),
              jnp.zeros((B, M_HEADS, M_HEAD_DIM), jnp.float32),
              jnp.zeros((B, M_HEADS), jnp.float32))
    _, hs = lax.scan(_mlstm_chunk, carry0, (chunks4(q), chunks4(k), chunks4(vh), li, lf))
    h = hs.transpose(1, 0, 3, 2, 4).reshape(B, S, M_HEADS, M_HEAD_DIM)
    h = h * lax.rsqrt(jnp.mean(h * h, axis=-1, keepdims=True) + EPS)
    h = (h.reshape(B, S, M_WIDTH) * out_norm.astype(jnp.float32)).astype(u.dtype)
    return jax.nn.sigmoid(o_pre) * (h + skip * ua)


def swa_branch(q, k, v, pos, q_norm, k_norm, sinks):
    B, S, _ = q.shape
    nc = S // CHUNK
    G = A_HEADS // A_KV_HEADS
    q = rope(rms_norm(q.reshape(B, S, A_HEADS, A_HEAD_DIM), q_norm), pos)
    k = rope(rms_norm(k.reshape(B, S, A_KV_HEADS, A_HEAD_DIM), k_norm), pos)
    v = v.reshape(B, S, A_KV_HEADS, A_HEAD_DIM)
    qb = q.reshape(B, nc, CHUNK, A_KV_HEADS, G, A_HEAD_DIM)

    def band(t):
        t = t.reshape(B, nc, CHUNK, A_KV_HEADS, A_HEAD_DIM)
        tp = jnp.pad(t, ((0, 0), (A_PREV_CHUNKS, 0), (0, 0), (0, 0), (0, 0)))
        return jnp.concatenate([tp[:, j:j + nc] for j in range(A_PREV_CHUNKS + 1)], axis=2)

    kb, vb = band(k), band(v)
    key_chunk = jnp.arange(nc)[:, None] - A_PREV_CHUNKS + jnp.arange(A_PREV_CHUNKS + 1)[None, :]
    valid = jnp.repeat(key_chunk >= 0, CHUNK, axis=1)
    s = jnp.einsum('bnqhgd,bnkhd->bnhgqk', qb, kb).astype(jnp.float32) * (A_HEAD_DIM ** -0.5)
    s = jnp.where(valid[None, :, None, None, None, :], s, -jnp.inf)
    sink = jnp.broadcast_to(sinks.astype(jnp.float32).reshape(1, 1, A_KV_HEADS, G, 1, 1),
                            s.shape[:-1] + (1,))
    p = jax.nn.softmax(jnp.concatenate([s, sink], axis=-1), axis=-1)[..., :-1]
    o = jnp.einsum('bnhgqk,bnkhd->bnqhgd', p.astype(v.dtype), vb)
    return o.reshape(B, S, A_Q_WIDTH)


def hybrid_mixer(h, pos, w_in, m_gate_b, m_conv_w, m_conv_b, m_wq, m_wk, m_out_norm, m_skip,
                 a_q_norm, a_k_norm, a_sinks, proj_a, proj_b, merge_w, merge_b, w_out):
    sizes = [M_WIDTH, M_WIDTH, M_WIDTH, M_HEADS, M_HEADS, A_Q_WIDTH, A_KV_WIDTH, A_KV_WIDTH]
    offs = [int(o) for o in np.cumsum(sizes)[:-1]]
    u, vm, om, im, fm, qa, ka, va = jnp.split(h @ w_in, offs, axis=-1)
    im = im + m_gate_b[:M_HEADS]
    fm = fm + m_gate_b[M_HEADS:]
    ya = mlstm_branch(u, vm, om, im, fm, m_conv_w, m_conv_b, m_wq, m_wk, m_out_norm, m_skip)
    yb = swa_branch(qa, ka, va, pos, a_q_norm, a_k_norm, a_sinks)
    ga, gb = jnp.split(jax.nn.sigmoid(h @ merge_w + merge_b), 2, axis=-1)
    merged = ga * (ya @ proj_a) + gb * (yb @ proj_b)
    return merged @ w_out


def setup_inputs(seed: int = 0) -> dict:
    key = jax.random.key(seed)
    ks = jax.random.split(key, 32)
    L, D, F = DEPTH, D_MODEL, D_FF
    nrm = jax.random.normal

    def gain(k, shape):
        return 1.0 + 0.02 * nrm(k, shape, jnp.float32)

    offsets = jax.random.randint(ks[2], (BATCH,), 0, 64) * CHUNK
    positions = (offsets[:, None] + jnp.arange(SEQ, dtype=jnp.int32)[None, :]).astype(jnp.int32)
    m_gate_b = jnp.concatenate([0.1 * nrm(ks[8], (L, M_HEADS), jnp.float32),
                                jax.random.uniform(ks[9], (L, M_HEADS), jnp.float32, 3.0, 6.0)], axis=-1)
    return {
        'x': nrm(ks[0], (BATCH, SEQ, D), jnp.float32),
        'c': nrm(ks[1], (BATCH, D), jnp.float32),
        'positions': positions,
        'ada_w': 0.5 * D ** -0.5 * nrm(ks[3], (L, D, 9 * D), jnp.float32),
        'ada_b': 0.01 * nrm(ks[4], (L, 9 * D), jnp.float32),
        'ffn1_norm': gain(ks[5], (L, D)),
        'ffn1_w_in': D ** -0.5 * nrm(ks[6], (L, D, 2 * F), jnp.float32),
        'ffn1_w_out': F ** -0.5 * nrm(ks[7], (L, F, D), jnp.float32),
        'mix_norm': gain(ks[10], (L, D)),
        'mix_w_in': D ** -0.5 * nrm(ks[11], (L, D, N_IN), jnp.float32),
        'm_gate_b': m_gate_b,
        'm_conv_w': M_CONV ** -0.5 * nrm(ks[12], (L, M_CONV, M_WIDTH), jnp.float32),
        'm_conv_b': 0.01 * nrm(ks[13], (L, M_WIDTH), jnp.float32),
        'm_wq': M_HEAD_DIM ** -0.5 * nrm(ks[14], (L, M_HEADS, M_HEAD_DIM, M_HEAD_DIM), jnp.float32),
        'm_wk': M_HEAD_DIM ** -0.5 * nrm(ks[15], (L, M_HEADS, M_HEAD_DIM, M_HEAD_DIM), jnp.float32),
        'm_out_norm': gain(ks[16], (L, M_WIDTH)),
        'm_skip': gain(ks[17], (L, M_WIDTH)),
        'a_q_norm': gain(ks[18], (L, A_HEAD_DIM)),
        'a_k_norm': gain(ks[19], (L, A_HEAD_DIM)),
        'a_sinks': nrm(ks[20], (L, A_HEADS), jnp.float32),
        'proj_a': M_WIDTH ** -0.5 * nrm(ks[21], (L, M_WIDTH, D), jnp.float32),
        'proj_b': A_Q_WIDTH ** -0.5 * nrm(ks[22], (L, A_Q_WIDTH, D), jnp.float32),
        'merge_w': D ** -0.5 * nrm(ks[23], (L, D, 2 * D), jnp.float32),
        'merge_b': 0.01 * nrm(ks[24], (L, 2 * D), jnp.float32),
        'w_out': D ** -0.5 * nrm(ks[25], (L, D, D), jnp.float32),
        'ffn2_norm': gain(ks[26], (L, D)),
        'ffn2_w_in': D ** -0.5 * nrm(ks[27], (L, D, 2 * F), jnp.float32),
        'ffn2_w_out': F ** -0.5 * nrm(ks[28], (L, F, D), jnp.float32),
    }


def reference(x, c, positions, ada_w, ada_b, ffn1_norm, ffn1_w_in, ffn1_w_out, mix_norm, mix_w_in,
              m_gate_b, m_conv_w, m_conv_b, m_wq, m_wk, m_out_norm, m_skip, a_q_norm, a_k_norm,
              a_sinks, proj_a, proj_b, merge_w, merge_b, w_out, ffn2_norm, ffn2_w_in, ffn2_w_out):
    c_act = jax.nn.silu(c)
    for l in range(DEPTH):
        mod = (c_act @ ada_w[l] + ada_b[l])[:, None, :]
        sh1, sc1, g1, sh2, sc2, g2, sh3, sc3, g3 = jnp.split(mod, 9, axis=-1)
        h = modulate(x, ffn1_norm[l], sh1, sc1)
        x = x + 0.5 * g1 * swiglu(h, ffn1_w_in[l], ffn1_w_out[l])
        h = modulate(x, mix_norm[l], sh2, sc2)
        x = x + g2 * hybrid_mixer(h, positions, mix_w_in[l], m_gate_b[l], m_conv_w[l], m_conv_b[l],
                                  m_wq[l], m_wk[l], m_out_norm[l], m_skip[l], a_q_norm[l],
                                  a_k_norm[l], a_sinks[l], proj_a[l], proj_b[l], merge_w[l],
                                  merge_b[l], w_out[l])
        h = modulate(x, ffn2_norm[l], sh3, sc3)
        x = x + 0.5 * g3 * swiglu(h, ffn2_w_in[l], ffn2_w_out[l])
    return x
```

```cpp
#include <hip/hip_runtime.h>
#include <hip/hip_cooperative_groups.h>
#include <cstdio>
#include <cstdint>
namespace cg = cooperative_groups;

#define LAS __attribute__((address_space(3)))
#define GAS __attribute__((address_space(1)))
typedef unsigned short bf16_t;
typedef short bf16x8 __attribute__((ext_vector_type(8)));
typedef short bf16x4 __attribute__((ext_vector_type(4)));
typedef float f32x4 __attribute__((ext_vector_type(4)));
typedef float f32x2 __attribute__((ext_vector_type(2)));
typedef unsigned u32x4 __attribute__((ext_vector_type(4)));
typedef unsigned u32x2 __attribute__((ext_vector_type(2)));

constexpr int DM = 1024, NB = 16, SEQ = 2048, T = NB * SEQ, FF = 2816, NIN = 4616;
constexpr int PW = 4608;
constexpr int C_U = 0, C_V = 1024, C_O = 2048, C_Q = 3072, C_K = 4096, C_VA = 4352;
constexpr float EPS = 1e-6f;
constexpr size_t MiB = 1u << 20;
constexpr size_t WS_MOD = 64 * 1024, WS_IF = 2 * MiB, WS_SSQ = 3 * MiB, WS_W = 4 * MiB, WS_H = 24 * MiB, WS_UA = 88 * MiB, WS_KM = 152 * MiB, WS_PROJ = 216 * MiB, WS_END = 504 * MiB;
constexpr size_t W_MIX = 0, W_MERGE = 9 * MiB, W_PA = 13 * MiB, W_PB = 15 * MiB, W_WO = 17 * MiB, W_QK = 19 * MiB;
constexpr size_t W_F1 = 0, W_F2 = 11 * MiB;
constexpr int LDS_BYTES = 147456;
#ifndef STOP_L
#define STOP_L 9
#endif
#ifndef STOP_STAGE
#define STOP_STAGE 9
#endif

__device__ __forceinline__ int opaque_tid(int wid_s) { int t; asm volatile("v_mbcnt_lo_u32_b32 %0, -1, 0\n\tv_mbcnt_hi_u32_b32 %0, -1, %0\n\tv_lshl_or_b32 %0, %1, 6, %0" : "=&v"(t) : "s"(wid_s)); return t; }
#define VBX_LDS_ADDR 147448u
__device__ __forceinline__ int opaque_bx() { int b = *(volatile LAS int*)VBX_LDS_ADDR; b = __builtin_amdgcn_readfirstlane(b); asm volatile("" : "+s"(b)); return b; }
__device__ __forceinline__ int row_cu(int c, int G) { return (G == 256) ? ((c & 7) * 32 + (c >> 3)) : c; }
typedef __bf16 bf16x2_t __attribute__((ext_vector_type(2)));
__device__ __forceinline__ unsigned cvt_pk_bf16(float lo, float hi) { const f32x2 v = {lo, hi}; return __builtin_bit_cast(unsigned, __builtin_convertvector(v, bf16x2_t)); }
__device__ __forceinline__ float bf2f(bf16_t x) { return __uint_as_float((unsigned)x << 16); }
__device__ __forceinline__ float bflo(unsigned x) { return __uint_as_float(x << 16); }
__device__ __forceinline__ float bfhi(unsigned x) { return __uint_as_float(x & 0xffff0000u); }
__device__ __forceinline__ bf16_t f2bf(float f) { return (bf16_t)(cvt_pk_bf16(f, 0.f) & 0xffffu); }
__device__ __forceinline__ float fexp(float x) { return __builtin_amdgcn_exp2f(x * 1.44269504088896f); }
__device__ __forceinline__ float fsigmoid(float x) { return __builtin_amdgcn_rcpf(1.0f + fexp(-x)); }
__device__ __forceinline__ float fsilu(float x) { return x * fsigmoid(x); }
__device__ __forceinline__ float shx(float v, int lane, int o) { return __int_as_float(__builtin_amdgcn_ds_bpermute((lane ^ o) << 2, __float_as_int(v))); }
__device__ __forceinline__ float shi(float v, int idx) { return __int_as_float(__builtin_amdgcn_ds_bpermute(idx << 2, __float_as_int(v))); }
__device__ __forceinline__ float wave_sum(float v, int lane) {
#pragma unroll
    for (int o = 1; o < 64; o <<= 1) v += shx(v, lane, o);
    return v;
}
#define DPP_F(old_, src_, ctrl_, rm_) __int_as_float(__builtin_amdgcn_update_dpp(__float_as_int(old_), __float_as_int(src_), (ctrl_), (rm_), 0xf, false))
__device__ __forceinline__ float scan_sum64(float v) {
    v += DPP_F(0.f, v, 0x111, 0xf); v += DPP_F(0.f, v, 0x112, 0xf); v += DPP_F(0.f, v, 0x114, 0xf); v += DPP_F(0.f, v, 0x118, 0xf);
    v += DPP_F(0.f, v, 0x142, 0xa); v += DPP_F(0.f, v, 0x143, 0xc); return v; }
__device__ __forceinline__ float scan_max64(float v) {
    const float ninf = -__builtin_inff();
    v = fmaxf(v, DPP_F(ninf, v, 0x111, 0xf)); v = fmaxf(v, DPP_F(ninf, v, 0x112, 0xf)); v = fmaxf(v, DPP_F(ninf, v, 0x114, 0xf)); v = fmaxf(v, DPP_F(ninf, v, 0x118, 0xf));
    v = fmaxf(v, DPP_F(ninf, v, 0x142, 0xa)); v = fmaxf(v, DPP_F(ninf, v, 0x143, 0xc)); return v; }
__device__ const float INV_FREQ[32] = {
1.0000000000e+00f, 7.4989420933e-01f, 5.6234132519e-01f, 4.2169650343e-01f, 3.1622776602e-01f, 2.3713737057e-01f, 1.7782794100e-01f, 1.3335214322e-01f,
1.0000000000e-01f, 7.4989420933e-02f, 5.6234132519e-02f, 4.2169650343e-02f, 3.1622776602e-02f, 2.3713737057e-02f, 1.7782794100e-02f, 1.3335214322e-02f,
1.0000000000e-02f, 7.4989420933e-03f, 5.6234132519e-03f, 4.2169650343e-03f, 3.1622776602e-03f, 2.3713737057e-03f, 1.7782794100e-03f, 1.3335214322e-03f,
1.0000000000e-03f, 7.4989420933e-04f, 5.6234132519e-04f, 4.2169650343e-04f, 3.1622776602e-04f, 2.3713737057e-04f, 1.7782794100e-04f, 1.3335214322e-04f};
#define MFMA16(a, b, c) __builtin_amdgcn_mfma_f32_16x16x32_bf16((a), (b), (c), 0, 0, 0)

namespace pg8 {
constexpr int BM = 256, BK = 64, HALF = 128, HTB = HALF * BK * 2, STAGE_BYTES = 8 * HTB, NXCD = 8, WGM = 8;
__host__ __device__ __forceinline__ int lds_byte(int r, int c) { const int st = (r >> 4) * 2 + (c >> 5), rr = r & 15, cc = c & 31, ob = rr * 64 + cc * 2; return st * 1024 + (ob ^ (((ob >> 9) & 1) << 5)); }
__host__ __device__ __forceinline__ void stage_rc(int b, int& R, int& C) { const int st = b / 1024, sb = b % 1024, swz = sb ^ (((sb >> 9) & 1) << 5); R = (st >> 1) * 16 + swz / 64; C = (st & 1) * 32 + (swz % 64) / 2; }
__host__ __device__ __forceinline__ int perm32(int rho) { const int n = rho >> 4, i = rho & 15; return 8 * (i >> 2) + 4 * n + (i & 3); }

struct Unit { int pm, pn; };
struct Gemm { const GAS bf16_t* A; const GAS bf16_t* Bt; int M, N, K, lda, ldb, agrp; size_t agoff; };

struct StaticOrder {
    int nM, nN, nwg, G, c;
    __host__ __device__ void init(int M, int N, int G_, int c_) { nM = M / BM; nN = N / BM; nwg = nM * nN; G = G_; c = c_; }
    __host__ __device__ bool next(int i, Unit& u) const {
        const long L = (long)i * G + c; if (L >= nwg) return false;
        int wgid = (int)L; { const int q = nwg / NXCD, r = nwg % NXCD, xcd = wgid % NXCD, off = wgid / NXCD; wgid = (xcd < r ? xcd * (q + 1) : r * (q + 1) + (xcd - r) * q) + off; }
        const int nig = WGM * nN, gid = wgid / nig, fm = gid * WGM, gsz = (nM - fm) < WGM ? (nM - fm) : WGM;
        u.pm = fm + ((wgid % nig) % gsz); u.pn = (wgid % nig) / gsz; return true;
    }
};

typedef f32x4 AccT[2][2][4][2];

struct EpiStore2 {
    static constexpr bool PERM = true;
    GAS bf16_t* O0; int ld0; GAS bf16_t* O1; int ld1; int split; const GAS float* bias; int act;
    __device__ __forceinline__ void operator()(const AccT& acc, const Unit& u, int wr, int wc, int fr, int fq) const {
        const int row0 = u.pm * BM + wr * 64 + fr;
        GAS bf16_t* base; int ld, ct;
        if (u.pn < split) { base = O0; ld = ld0; ct = u.pn; } else { base = O1; ld = ld1; ct = u.pn - split; }
        const int col0 = ct * BM + wc * 32 + 8 * fq, bcol0 = u.pn * BM + wc * 32 + 8 * fq;
#pragma unroll
        for (int bj = 0; bj < 2; ++bj) {
            f32x4 b0 = (f32x4){0.f, 0.f, 0.f, 0.f}, b1 = b0;
            if (act) { b0 = *(const GAS f32x4*)(bias + bcol0 + bj * HALF) * -1.4426950408889634f; b1 = *(const GAS f32x4*)(bias + bcol0 + bj * HALF + 4) * -1.4426950408889634f; }
#pragma unroll
            for (int ai = 0; ai < 2; ++ai)
#pragma unroll
                for (int m = 0; m < 4; ++m) {
                    f32x4 v0 = acc[ai][bj][m][0], v1 = acc[ai][bj][m][1];
                    if (act) { v0 += b0; v1 += b1;
#pragma unroll
                        for (int e = 0; e < 4; ++e) { v0[e] = __builtin_amdgcn_rcpf(1.0f + __builtin_amdgcn_exp2f(v0[e])); v1[e] = __builtin_amdgcn_rcpf(1.0f + __builtin_amdgcn_exp2f(v1[e])); } }
                    u32x4 w; w.x = cvt_pk_bf16(v0[0], v0[1]); w.y = cvt_pk_bf16(v0[2], v0[3]); w.z = cvt_pk_bf16(v1[0], v1[1]); w.w = cvt_pk_bf16(v1[2], v1[3]);
                    *(GAS u32x4*)(base + (size_t)(row0 + ai * HALF + m * 16) * ld + col0 + bj * HALF) = w;
                }
        }
    }
};
struct EpiQK {
    static constexpr bool PERM = true;
    GAS bf16_t* O0; int ld0; GAS bf16_t* O1; int ld1;
    __device__ __forceinline__ void operator()(const AccT& acc, const Unit& u, int wr, int wc, int fr, int fq) const {
        const int row0 = u.pm * BM + wr * 64 + fr, hd = u.pn >> 1;
        GAS bf16_t* base = (u.pn & 1) ? O1 : O0; const int ld = (u.pn & 1) ? ld1 : ld0;
        const int col0 = hd * BM + wc * 32 + 8 * fq;
#pragma unroll
        for (int bj = 0; bj < 2; ++bj)
#pragma unroll
            for (int ai = 0; ai < 2; ++ai)
#pragma unroll
                for (int m = 0; m < 4; ++m) {
                    const f32x4 v0 = acc[ai][bj][m][0], v1 = acc[ai][bj][m][1];
                    u32x4 w; w.x = cvt_pk_bf16(v0[0], v0[1]); w.y = cvt_pk_bf16(v0[2], v0[3]); w.z = cvt_pk_bf16(v1[0], v1[1]); w.w = cvt_pk_bf16(v1[2], v1[3]);
                    *(GAS u32x4*)(base + (size_t)(row0 + ai * HALF + m * 16) * ld + col0 + bj * HALF) = w;
                }
    }
};
struct EpiSwiGLU {
    static constexpr bool PERM = true;
    GAS bf16_t* O; int ldc;
    __device__ __forceinline__ void operator()(const AccT& acc, const Unit& u, int wr, int wc, int fr, int fq) const {
        const int row0 = u.pm * BM + wr * 64 + fr, col0 = u.pn * 128 + wc * 32 + 8 * fq;
#pragma unroll
        for (int ai = 0; ai < 2; ++ai)
#pragma unroll
            for (int m = 0; m < 4; ++m) {
                const f32x4 a0 = acc[ai][0][m][0], a1 = acc[ai][0][m][1], g0 = acc[ai][1][m][0], g1 = acc[ai][1][m][1];
                f32x4 r0, r1;
#pragma unroll
                for (int e = 0; e < 4; ++e) { r0[e] = a0[e] * g0[e] * __builtin_amdgcn_rcpf(1.0f + __builtin_amdgcn_exp2f(a0[e])); r1[e] = a1[e] * g1[e] * __builtin_amdgcn_rcpf(1.0f + __builtin_amdgcn_exp2f(a1[e])); }
                u32x4 w; w.x = cvt_pk_bf16(r0[0], r0[1]); w.y = cvt_pk_bf16(r0[2], r0[3]); w.z = cvt_pk_bf16(r1[0], r1[1]); w.w = cvt_pk_bf16(r1[2], r1[3]);
                *(GAS u32x4*)(O + (size_t)(row0 + ai * HALF + m * 16) * ldc + col0) = w;
            }
    }
};
template <int MODE> struct EpiGate {
    static constexpr bool PERM = true;
    GAS bf16_t* O; int ldo; const GAS bf16_t* Gt; int ldg;
    __device__ __forceinline__ void operator()(const AccT& acc, const Unit& u, int wr, int wc, int fr, int fq) const {
        const int row0 = u.pm * BM + wr * 64 + fr, col0 = u.pn * BM + wc * 32 + 8 * fq;
#pragma unroll
        for (int bj = 0; bj < 2; ++bj)
#pragma unroll
            for (int ai = 0; ai < 2; ++ai)
#pragma unroll
                for (int m = 0; m < 4; ++m) {
                    const size_t r = (size_t)(row0 + ai * HALF + m * 16);
                    const u32x4 gv = *(const GAS u32x4*)(Gt + r * ldg + col0 + bj * HALF);
                    GAS bf16_t* op = O + r * ldo + col0 + bj * HALF;
                    f32x4 v0 = acc[ai][bj][m][0], v1 = acc[ai][bj][m][1];
                    v0[0] *= bflo(gv.x); v0[1] *= bfhi(gv.x); v0[2] *= bflo(gv.y); v0[3] *= bfhi(gv.y);
                    v1[0] *= bflo(gv.z); v1[1] *= bfhi(gv.z); v1[2] *= bflo(gv.w); v1[3] *= bfhi(gv.w);
                    if (MODE == 1) { const u32x4 tv = *(const GAS u32x4*)op;
                        v0[0] += bflo(tv.x); v0[1] += bfhi(tv.x); v0[2] += bflo(tv.y); v0[3] += bfhi(tv.y);
                        v1[0] += bflo(tv.z); v1[1] += bfhi(tv.z); v1[2] += bflo(tv.w); v1[3] += bfhi(tv.w); }
                    u32x4 w; w.x = cvt_pk_bf16(v0[0], v0[1]); w.y = cvt_pk_bf16(v0[2], v0[3]); w.z = cvt_pk_bf16(v1[0], v1[1]); w.w = cvt_pk_bf16(v1[2], v1[3]);
                    *(GAS u32x4*)op = w;
                }
    }
};
struct EpiRes {
    static constexpr bool PERM = true;
    const GAS void* xin; GAS void* out; const GAS float* gate; int gstride; float scale; int in_f32, out_f32;
    __device__ __forceinline__ void operator()(const AccT& acc, const Unit& u, int wr, int wc, int fr, int fq) const {
        const int row0 = u.pm * BM + wr * 64 + fr, col0 = u.pn * BM + wc * 32 + 8 * fq;
        const GAS float* gp = gate + (size_t)(u.pm >> 3) * gstride;
#pragma unroll
        for (int bj = 0; bj < 2; ++bj) {
            const f32x4 g0 = *(const GAS f32x4*)(gp + col0 + bj * HALF) * scale, g1 = *(const GAS f32x4*)(gp + col0 + bj * HALF + 4) * scale;
#pragma unroll
            for (int ai = 0; ai < 2; ++ai)
#pragma unroll
                for (int m = 0; m < 4; ++m) {
                    const size_t off = (size_t)(row0 + ai * HALF + m * 16) * DM + col0 + bj * HALF;
                    f32x4 x0, x1;
                    if (in_f32) { x0 = *(const GAS f32x4*)((const GAS float*)xin + off); x1 = *(const GAS f32x4*)((const GAS float*)xin + off + 4); }
                    else { const u32x4 v = *(const GAS u32x4*)((const GAS bf16_t*)xin + off);
                        x0 = (f32x4){bflo(v.x), bfhi(v.x), bflo(v.y), bfhi(v.y)}; x1 = (f32x4){bflo(v.z), bfhi(v.z), bflo(v.w), bfhi(v.w)}; }
                    const f32x4 y0 = x0 + g0 * acc[ai][bj][m][0], y1 = x1 + g1 * acc[ai][bj][m][1];
                    if (out_f32) { *(GAS f32x4*)((GAS float*)out + off) = y0; *(GAS f32x4*)((GAS float*)out + off + 4) = y1; }
                    else { u32x4 w; w.x = cvt_pk_bf16(y0[0], y0[1]); w.y = cvt_pk_bf16(y0[2], y0[3]); w.z = cvt_pk_bf16(y1[0], y1[1]); w.w = cvt_pk_bf16(y1[2], y1[3]);
                        *(GAS u32x4*)((GAS bf16_t*)out + off) = w; }
                }
        }
    }
};

template <class Epi>
__device__ __forceinline__ void gemm_phase(int wid_s, LAS unsigned char* lds, const Gemm g, const StaticOrder& S, const Epi& E) {
    const int tid = opaque_tid(wid_s), wid = __builtin_amdgcn_readfirstlane(tid >> 6), lane = tid & 63, wr = wid >> 2, wc = wid & 3, fr = lane & 15, fq = lane >> 4;
    const int K = g.K, nt = K / BK;
    unsigned voffA[2], voffB[2];
#pragma unroll
    for (int i = 0; i < 2; ++i) { int R, C; stage_rc(tid * 16 + i * 8192, R, C); const int Rb = Epi::PERM ? ((R & ~31) + perm32(R & 31)) : R;
        voffA[i] = (unsigned)(R * g.lda + C) * 2u; voffB[i] = (unsigned)(Rb * g.ldb + C) * 2u; }
    const size_t kstep = (size_t)(BK * 2);
    const size_t hsA = (size_t)HALF * g.lda * 2, hsB = (size_t)HALF * g.ldb * 2;
    const size_t tsA = 2 * hsA, tsB = 2 * hsB;
    const unsigned ldsw = (unsigned)wid * 1024u;
    const int aoff = lds_byte(wr * 64 + fr, fq * 8), boff = lds_byte(wc * 32 + fr, fq * 8);
#define PG8_SA(b, h) (((b) * 2 + (h)) * HTB)
#define PG8_SB(b, h) ((4 + (b) * 2 + (h)) * HTB)
#define PG8_STAGE(bufoff, gbase, voff) do { _Pragma("unroll") for (int _i = 0; _i < 2; ++_i) \
        __builtin_amdgcn_global_load_lds((const GAS unsigned*)((const GAS char*)(gbase) + (voff)[_i]), (LAS unsigned*)(lds + (bufoff) + ldsw + _i * 8192), 16, 0, 0); } while (0)
#define PG8_LDA(dst, b, h) do { _Pragma("unroll") for (int m = 0; m < 4; ++m) _Pragma("unroll") for (int k = 0; k < 2; ++k) dst[m][k] = *(const LAS bf16x8*)(lds + PG8_SA(b, h) + aoff + m * 2048 + k * 1024); } while (0)
#define PG8_LDB(dst, b, h) do { _Pragma("unroll") for (int n = 0; n < 2; ++n) _Pragma("unroll") for (int k = 0; k < 2; ++k) dst[n][k] = *(const LAS bf16x8*)(lds + PG8_SB(b, h) + boff + n * 2048 + k * 1024); } while (0)
#define PG8_MMA(ai, bj, At, Bt) do { __builtin_amdgcn_s_setprio(1); _Pragma("unroll") for (int m = 0; m < 4; ++m) _Pragma("unroll") for (int n = 0; n < 2; ++n) _Pragma("unroll") for (int k = 0; k < 2; ++k) \
        acc[ai][bj][m][n] = __builtin_amdgcn_mfma_f32_16x16x32_bf16(Bt[n][k], At[m][k], acc[ai][bj][m][n], 0, 0, 0); __builtin_amdgcn_s_setprio(0); } while (0)
#define PG8_WAIT_V(n) asm volatile("s_waitcnt vmcnt(" #n ")" ::: "memory")
#define PG8_WAIT_L(n) asm volatile("s_waitcnt lgkmcnt(" #n ")" ::: "memory")
#define PG8_BAR __builtin_amdgcn_s_barrier()
#define PG8_SCHED __builtin_amdgcn_sched_barrier(0)
#define PG8_ABASE(u) ((const GAS char*)g.A + (size_t)(u).pm * tsA + (size_t)((u).pn / g.agrp) * g.agoff)
    Unit cur, nxt; int ui = 0;
    if (!S.next(0, cur)) return;
    f32x4 acc[2][2][4][2];
#pragma unroll
    for (int a = 0; a < 2; ++a)
#pragma unroll
        for (int b = 0; b < 2; ++b)
#pragma unroll
            for (int m = 0; m < 4; ++m)
#pragma unroll
                for (int n = 0; n < 2; ++n) acc[a][b][m][n] = (f32x4){0.f, 0.f, 0.f, 0.f};
    bf16x8 At[4][2], B0[2][2], B1[2][2];
    const GAS char* cA = PG8_ABASE(cur); const GAS char* cB = (const GAS char*)g.Bt + (size_t)cur.pn * tsB;
    PG8_STAGE(PG8_SB(0, 0), cB, voffB); PG8_STAGE(PG8_SB(0, 1), cB + hsB, voffB); PG8_STAGE(PG8_SA(0, 0), cA, voffA); PG8_STAGE(PG8_SA(0, 1), cA + hsA, voffA);
    if (wr == 1) PG8_BAR;
    PG8_WAIT_V(2); PG8_BAR;
    PG8_STAGE(PG8_SB(1, 0), cB + kstep, voffB); PG8_STAGE(PG8_SA(1, 0), cA + kstep, voffA); PG8_STAGE(PG8_SB(1, 1), cB + hsB + kstep, voffB);
    PG8_WAIT_V(6); PG8_BAR;
    for (;;) {
        const bool has_next = S.next(ui + 1, nxt);
        const GAS char* nA = has_next ? PG8_ABASE(nxt) : cA; const GAS char* nB = has_next ? (const GAS char*)g.Bt + (size_t)nxt.pn * tsB : cB;
        for (int t = 0; t < nt; t += 2) {
            const bool last = (t == nt - 2);
            const GAS char* a1 = cA + (size_t)(t + 1) * kstep;
            const GAS char* a2 = last ? nA : cA + (size_t)(t + 2) * kstep; const GAS char* b2 = last ? nB : cB + (size_t)(t + 2) * kstep;
            const GAS char* a3 = a2 + kstep; const GAS char* b3 = b2 + kstep;
            PG8_LDB(B0, 0, 0); PG8_LDB(B1, 0, 1); PG8_SCHED; PG8_LDA(At, 0, 0); PG8_STAGE(PG8_SA(1, 1), a1 + hsA, voffA);
            PG8_WAIT_V(8); PG8_WAIT_L(0); PG8_BAR; PG8_MMA(0, 0, At, B0); PG8_MMA(0, 1, At, B1); PG8_BAR; PG8_SCHED;
            PG8_LDA(At, 0, 1); PG8_STAGE(PG8_SB(0, 0), b2, voffB); PG8_STAGE(PG8_SB(0, 1), b2 + hsB, voffB); PG8_STAGE(PG8_SA(0, 0), a2, voffA);
            PG8_WAIT_V(8); PG8_WAIT_L(0); PG8_BAR; PG8_MMA(1, 0, At, B0); PG8_MMA(1, 1, At, B1); PG8_BAR; PG8_SCHED;
            PG8_LDB(B0, 1, 0); PG8_LDB(B1, 1, 1); PG8_SCHED; PG8_LDA(At, 1, 0); PG8_STAGE(PG8_SA(0, 1), a2 + hsA, voffA);
            PG8_WAIT_V(8); PG8_WAIT_L(0); PG8_BAR; PG8_MMA(0, 0, At, B0); PG8_MMA(0, 1, At, B1); PG8_BAR; PG8_SCHED;
            PG8_LDA(At, 1, 1); PG8_STAGE(PG8_SB(1, 0), b3, voffB); PG8_STAGE(PG8_SB(1, 1), b3 + hsB, voffB); PG8_STAGE(PG8_SA(1, 0), a3, voffA);
            PG8_WAIT_V(8); PG8_WAIT_L(0); PG8_BAR; PG8_MMA(1, 0, At, B0); PG8_MMA(1, 1, At, B1); PG8_BAR; PG8_SCHED;
        }
        if (wr == 0) PG8_BAR;
        { const int le = opaque_tid(wid_s) & 63; E(acc, cur, wr, wc, le & 15, le >> 4); }
        if (!has_next) break;
#pragma unroll
        for (int a = 0; a < 2; ++a)
#pragma unroll
            for (int b = 0; b < 2; ++b)
#pragma unroll
                for (int m = 0; m < 4; ++m)
#pragma unroll
                    for (int n = 0; n < 2; ++n) acc[a][b][m][n] = (f32x4){0.f, 0.f, 0.f, 0.f};
        cur = nxt; cA = nA; cB = nB; ++ui;
        if (wr == 1) PG8_BAR;
    }
    PG8_WAIT_V(0);
    PG8_BAR;
#undef PG8_SA
#undef PG8_SB
#undef PG8_STAGE
#undef PG8_LDA
#undef PG8_LDB
#undef PG8_MMA
#undef PG8_WAIT_V
#undef PG8_WAIT_L
#undef PG8_BAR
#undef PG8_SCHED
#undef PG8_ABASE
}
}

struct Params { const float* in[28]; float* out; unsigned char* ws; };
enum { I_X = 0, I_C, I_POS, I_ADAW, I_ADAB, I_F1N, I_F1WI, I_F1WO, I_MIXN, I_MIXW, I_GATEB, I_CONVW, I_CONVB, I_WQ, I_WK, I_ONORM, I_SKIP, I_QN, I_KN, I_SINK,
       I_PA, I_PB, I_MERGEW, I_MERGEB, I_WOUT, I_F2N, I_F2WI, I_F2WO };

__device__ __forceinline__ void cvt_item(const GAS float* W, int Nsrc, int K, GAS bf16_t* WT, int nblk, int item, int mode, float scale, LAS float* scr, int lane) {
    const int kb = item / nblk, nb = item % nblk, k0 = 64 * kb, n0 = 32 * nb;
    const int n = n0 + (lane & 31);
    const float scl = (mode == 2) ? ((n & 128) ? -0.6931471805599453f : -1.4426950408889634f) : scale;
    const int sc = mode == 0 ? n : (mode == 1 ? (n < 3072 ? n : n + 8) : (((n & 128) ? FF : 0) + (n >> 8) * 128 + (n & 127)));
    float tmpw[32];
#pragma unroll
    for (int i = 0; i < 32; ++i) tmpw[i] = W[(size_t)(k0 + 2 * i + (lane >> 5)) * Nsrc + sc];
#pragma unroll
    for (int i = 0; i < 32; ++i) scr[(2 * i + (lane >> 5)) * 33 + (lane & 31)] = tmpw[i] * scl;
    asm volatile("s_waitcnt lgkmcnt(0)" ::: "memory");
    const int c = lane & 7;
#pragma unroll
    for (int j = 0; j < 4; ++j) { const int nn = (lane >> 3) + 8 * j; const LAS float* s = scr + (8 * c) * 33 + nn;
        u32x4 o; o.x = cvt_pk_bf16(s[0 * 33], s[1 * 33]); o.y = cvt_pk_bf16(s[2 * 33], s[3 * 33]); o.z = cvt_pk_bf16(s[4 * 33], s[5 * 33]); o.w = cvt_pk_bf16(s[6 * 33], s[7 * 33]);
        *(GAS u32x4*)(WT + (size_t)(n0 + nn) * K + k0 + 8 * c) = o; }
    asm volatile("s_waitcnt lgkmcnt(0)" ::: "memory");
}
struct CvtJob { const GAS float* W; int Nsrc, K, Ndst; GAS bf16_t* WT; int mode; float scale; };
__device__ __forceinline__ void cvt_run(const CvtJob& j, int& base, int gw, int NGW, LAS float* scr, int lane) {
    const int nblk = j.Ndst / 32, items = (j.K / 64) * nblk;
    int it = gw - (base % NGW); if (it < 0) it += NGW;
    for (; it < items; it += NGW) cvt_item(j.W, j.Nsrc, j.K, j.WT, nblk, it, j.mode, j.scale, scr, lane);
    base += items;
}

__device__ __forceinline__ void mod_phase(int wid_s, LAS unsigned char* lds, const GAS float* c, const GAS float* adaw, const GAS float* adab, GAS float* MOD) {
    const int tid = opaque_tid(wid_s), w = tid >> 6, lane = tid & 63;
    LAS float* sc = (LAS float*)lds;
    LAS float* red = (LAS float*)(lds + 65536);
    for (int i = tid; i < NB * DM; i += 512) sc[i] = fsilu(c[i]);
    __syncthreads();
    for (int item = opaque_bx(); item < 256; item += gridDim.x) {
        const int l = item >> 7, j0 = (item & 127) * 72;
        const GAS float* wp = adaw + (size_t)l * DM * 9216 + j0 + lane;
        const bool has2 = lane < 8;
        float acc[16], acc2[16];
#pragma unroll
        for (int b = 0; b < 16; ++b) { acc[b] = 0.f; acc2[b] = 0.f; }
#pragma unroll 2
        for (int k = w * 128; k < w * 128 + 128; k += 4) {
            const float w0 = wp[(size_t)k * 9216], w1 = wp[(size_t)(k + 1) * 9216], w2 = wp[(size_t)(k + 2) * 9216], w3 = wp[(size_t)(k + 3) * 9216];
            float x0 = 0.f, x1 = 0.f, x2 = 0.f, x3 = 0.f;
            if (has2) { x0 = wp[(size_t)k * 9216 + 64]; x1 = wp[(size_t)(k + 1) * 9216 + 64]; x2 = wp[(size_t)(k + 2) * 9216 + 64]; x3 = wp[(size_t)(k + 3) * 9216 + 64]; }
#pragma unroll
            for (int b = 0; b < 16; ++b) { const f32x4 sv = *(const LAS f32x4*)(sc + b * DM + k);
                acc[b] += sv[0] * w0 + sv[1] * w1 + sv[2] * w2 + sv[3] * w3; acc2[b] += sv[0] * x0 + sv[1] * x1 + sv[2] * x2 + sv[3] * x3; }
        }
#pragma unroll
        for (int b = 0; b < 16; ++b) { red[(w * 16 + b) * 72 + lane] = acc[b]; if (has2) red[(w * 16 + b) * 72 + 64 + lane] = acc2[b]; }
        __syncthreads();
        for (int o = tid; o < 16 * 72; o += 512) { const int b = o / 72, j = o % 72; float sm = adab[l * 9216 + j0 + j];
#pragma unroll
            for (int ww = 0; ww < 8; ++ww) sm += red[(ww * 16 + b) * 72 + j];
            MOD[((size_t)l * NB + b) * 9216 + j0 + j] = sm; }
        __syncthreads();
    }
}

template <bool GATES>
__device__ __forceinline__ void modulate_phase(int wid_s, LAS unsigned char* lds, const GAS void* xin, int in_f32, GAS bf16_t* xcopy, const GAS float* nw, const GAS float* modl, int shc, GAS bf16_t* H,
                                               const GAS float* mixw, const GAS float* gateb, GAS float* IF, GAS float* SSQ) {
    const int tid = opaque_tid(wid_s), w = tid >> 6, lane = tid & 63;
    LAS float* Wg = (LAS float*)lds;
    if (GATES) { for (int i = tid; i < 8192; i += 512) { const int cc = i >> 3, gi = i & 7; Wg[gi * 1024 + cc] = mixw[(size_t)cc * NIN + 3072 + gi]; } __syncthreads(); }
    for (int blk = row_cu(opaque_bx(), gridDim.x); blk < T / 128; blk += gridDim.x) {
        const int b = blk >> 4;
        const GAS float* shp = modl + (size_t)b * 9216 + shc * 1024; const GAS float* scp = shp + 1024;
        f32x4 Af[4], Sf[4];
#pragma unroll
        for (int j = 0; j < 4; ++j) { const int cc = 4 * lane + 256 * j; const f32x4 n4 = *(const GAS f32x4*)(nw + cc), s4 = *(const GAS f32x4*)(scp + cc); Af[j] = n4 * (s4 + 1.0f); Sf[j] = *(const GAS f32x4*)(shp + cc); }
        if (GATES) SSQ[blk * 512 + tid] = 0.f;
        for (int rr = 0; rr < 16; ++rr) {
            const int row = blk * 128 + w * 16 + rr;
            f32x4 v[4]; float ss = 0.f;
            if (in_f32) { const GAS f32x4* xr = (const GAS f32x4*)((const GAS float*)xin + (size_t)row * DM) + lane;
#pragma unroll
                for (int j = 0; j < 4; ++j) v[j] = xr[64 * j]; }
            else { const GAS u32x2* xr = (const GAS u32x2*)((const GAS bf16_t*)xin + (size_t)row * DM) + lane;
#pragma unroll
                for (int j = 0; j < 4; ++j) { const u32x2 uv = xr[64 * j]; v[j] = (f32x4){bflo(uv.x), bfhi(uv.x), bflo(uv.y), bfhi(uv.y)};
                    if (xcopy) *((GAS u32x2*)(xcopy + (size_t)row * DM) + lane + 64 * j) = uv; } }
#pragma unroll
            for (int j = 0; j < 4; ++j) ss += (v[j][0] * v[j][0] + v[j][1] * v[j][1]) + (v[j][2] * v[j][2] + v[j][3] * v[j][3]);
            const float rstd = 1.0f / sqrtf(wave_sum(ss, lane) * (1.0f / DM) + EPS);
#pragma unroll
            for (int j = 0; j < 4; ++j) { v[j] = v[j] * rstd * Af[j] + Sf[j];
                u32x2 o; o.x = cvt_pk_bf16(v[j][0], v[j][1]); o.y = cvt_pk_bf16(v[j][2], v[j][3]);
                *((GAS u32x2*)(H + (size_t)row * DM) + lane + 64 * j) = o; }
            if (GATES) {
                float ga[8];
#pragma unroll
                for (int gi = 0; gi < 8; ++gi) { float a = 0.f;
#pragma unroll
                    for (int j = 0; j < 4; ++j) { const f32x4 wv = *(const LAS f32x4*)(Wg + gi * 1024 + 4 * lane + 256 * j); a += (v[j][0] * wv[0] + v[j][1] * wv[1]) + (v[j][2] * wv[2] + v[j][3] * wv[3]); }
                    ga[gi] = wave_sum(a, lane); }
                float mine = 0.f;
#pragma unroll
                for (int gi = 0; gi < 8; ++gi) mine = (lane == gi) ? ga[gi] : mine;
                if (lane < 8) { float pre = mine + gateb[lane];
                    if (lane >= 4) pre = fminf(pre, 0.f) - 0.6931471805599453f * __builtin_amdgcn_logf(1.0f + fexp(-fabsf(pre)));
                    IF[(size_t)row * 8 + lane] = pre; }
            }
        }
    }
}

__device__ __forceinline__ void conv_phase(int wid_s, const GAS bf16_t* PROJ, const GAS float* cw, const GAS float* cb, GAS bf16_t* UA) {
    const int tid = opaque_tid(wid_s), cg8 = (tid & 127) * 8, rg = tid >> 7;
    float wt[4][8], bb[8];
#pragma unroll
    for (int j = 0; j < 4; ++j)
#pragma unroll
        for (int e = 0; e < 8; ++e) wt[j][e] = cw[j * 1024 + cg8 + e];
#pragma unroll
    for (int e = 0; e < 8; ++e) bb[e] = cb[cg8 + e];
    const int G_ = gridDim.x, rc_ = row_cu(opaque_bx(), G_), per_ = (G_ == 256) ? 2 : 1;
    for (int it_ = rc_ * per_; it_ < T / 64; it_ += (it_ % per_ == per_ - 1) ? (G_ * per_ - (per_ - 1)) : 1) {
        const int item = it_;
        const int r0 = item * 64 + rg * 16;
        float p[3][8];
#pragma unroll
        for (int j = 0; j < 3; ++j) { const int tr = r0 - 3 + j; u32x4 v = (u32x4){0u, 0u, 0u, 0u};
            if ((r0 & (SEQ - 1)) - 3 + j >= 0) v = *(const GAS u32x4*)(PROJ + (size_t)tr * PW + C_U + cg8);
            p[j][0] = bflo(v.x); p[j][1] = bfhi(v.x); p[j][2] = bflo(v.y); p[j][3] = bfhi(v.y); p[j][4] = bflo(v.z); p[j][5] = bfhi(v.z); p[j][6] = bflo(v.w); p[j][7] = bfhi(v.w); }
#pragma unroll 8
        for (int rr = 0; rr < 16; ++rr) {
            const u32x4 v = *(const GAS u32x4*)(PROJ + (size_t)(r0 + rr) * PW + C_U + cg8);
            float cu[8] = {bflo(v.x), bfhi(v.x), bflo(v.y), bfhi(v.y), bflo(v.z), bfhi(v.z), bflo(v.w), bfhi(v.w)};
            float o[8];
#pragma unroll
            for (int e = 0; e < 8; ++e) { o[e] = fsilu(wt[0][e] * p[0][e] + wt[1][e] * p[1][e] + wt[2][e] * p[2][e] + wt[3][e] * cu[e] + bb[e]); p[0][e] = p[1][e]; p[1][e] = p[2][e]; p[2][e] = cu[e]; }
            u32x4 w; w.x = cvt_pk_bf16(o[0], o[1]); w.y = cvt_pk_bf16(o[2], o[3]); w.z = cvt_pk_bf16(o[4], o[5]); w.w = cvt_pk_bf16(o[6], o[7]);
            *(GAS u32x4*)(UA + (size_t)(r0 + rr) * DM + cg8) = w;
        }
    }
}

__device__ __forceinline__ void swa_phase(int wid_s, LAS unsigned char* lds, GAS bf16_t* PROJ, const GAS int* pos, const GAS float* qn, const GAS float* kn, const GAS float* sinks) {
    const int tid = opaque_tid(wid_s), w = tid >> 6, lane = tid & 63, fr = lane & 15, kq = lane >> 4;
    LAS bf16_t* Qs = (LAS bf16_t*)lds;
    LAS bf16_t* Ks = Qs + 256 * 72;
    LAS bf16_t* Vt = Ks + 192 * 72;
    LAS int* posl = (LAS int*)(Vt + 64 * 200);
    LAS float* nrm = (LAS float*)(posl + 256);
    if (tid < 64) nrm[tid] = qn[tid]; else if (tid < 128) nrm[tid] = kn[tid - 64];
    const int G_ = gridDim.x, rc_ = row_cu(opaque_bx(), G_), per_ = (G_ == 256) ? 8 : 1;
    u32x4 pk[3], pv[3]; int ppos = 0;
#define SWA_FETCH(u_) do { const int t_ = opaque_tid(wid_s); const int b_ = (u_) >> 7, n_ = ((u_) >> 2) & 31, hk_ = (u_) & 3, kc_ = n_ >= 2 ? n_ - 2 : 0, nk_ = (n_ - kc_ + 1) * 64; \
        const int tq_ = b_ * SEQ + n_ * 64, tk_ = b_ * SEQ + kc_ * 64; \
        _Pragma("unroll") for (int i = 0; i < 3; ++i) { const int p = t_ + 512 * i; \
            if (p < nk_ * 8) { const int r = p >> 3, pc = p & 7; \
                pk[i] = *(const GAS u32x4*)(PROJ + (size_t)(tk_ + r) * PW + C_K + hk_ * 64 + pc * 8); \
                pv[i] = *(const GAS u32x4*)(PROJ + (size_t)(tk_ + r) * PW + C_VA + hk_ * 64 + pc * 8); } } \
        if (t_ < 64) ppos = pos[tq_ + t_]; else if (t_ < 64 + nk_) ppos = pos[tk_ + t_ - 64]; } while (0)
    const int unit0_ = rc_ * per_;
    if (unit0_ < NB * 32 * 4) SWA_FETCH(unit0_);
    for (int unit = unit0_; unit < NB * 32 * 4; ) {
        const int unit_next = unit + ((unit % per_ == per_ - 1) ? (G_ * per_ - (per_ - 1)) : 1);
        const int tid = opaque_tid(wid_s), w = tid >> 6, lane = tid & 63, fr = lane & 15, kq = lane >> 4;
        const int b = unit >> 7, n = (unit >> 2) & 31, hk = unit & 3;
        const int kc0 = n >= 2 ? n - 2 : 0, nkeys = (n - kc0 + 1) * 64, nkt = nkeys >> 4;
        const int tq0 = b * SEQ + n * 64;
        __syncthreads();
#pragma unroll
        for (int i = 0; i < 4; ++i) { const int p = tid + 512 * i, r = p >> 3, pc = p & 7, g = r >> 6, qi = r & 63;
            *(LAS u32x4*)(Qs + r * 72 + pc * 8) = *(const GAS u32x4*)(PROJ + (size_t)(tq0 + qi) * PW + C_Q + (hk * 4 + g) * 64 + pc * 8); }
#pragma unroll
        for (int i = 0; i < 3; ++i) { const int p = tid + 512 * i;
            if (p < nkeys * 8) { const int r = p >> 3, pc = p & 7;
                *(LAS u32x4*)(Ks + r * 72 + pc * 8) = pk[i];
                const u32x4 vv = pv[i];
                LAS bf16_t* vp = Vt + (pc * 8) * 200 + r;
                vp[0] = (bf16_t)(vv.x & 0xffffu); vp[200] = (bf16_t)(vv.x >> 16); vp[400] = (bf16_t)(vv.y & 0xffffu); vp[600] = (bf16_t)(vv.y >> 16);
                vp[800] = (bf16_t)(vv.z & 0xffffu); vp[1000] = (bf16_t)(vv.z >> 16); vp[1200] = (bf16_t)(vv.w & 0xffffu); vp[1400] = (bf16_t)(vv.w >> 16); } }
        if (tid < 64 + nkeys) posl[tid] = ppos;
        if (unit_next < NB * 32 * 4) SWA_FETCH(unit_next);
        __syncthreads();
        if (tid < 256 + nkeys) {
            const bool isq = tid < 256;
            LAS bf16_t* rp = isq ? Qs + tid * 72 : Ks + (tid - 256) * 72;
            const LAS float* nw = nrm + (isq ? 0 : 64);
            unsigned xw[32];
#pragma unroll
            for (int i = 0; i < 8; ++i) { const u32x4 v = *(const LAS u32x4*)(rp + 8 * i); xw[4 * i] = v.x; xw[4 * i + 1] = v.y; xw[4 * i + 2] = v.z; xw[4 * i + 3] = v.w; }
            float ss = 0.f;
#pragma unroll
            for (int j = 0; j < 32; ++j) { const float a = bflo(xw[j]), b = bfhi(xw[j]); ss += a * a + b * b; }
            const float rstd = 1.0f / sqrtf(ss * (1.0f / 64.0f) + EPS);
            const float pf = (float)posl[isq ? (tid & 63) : (64 + tid - 256)];
#pragma unroll
            for (int j = 0; j < 16; ++j) {
                float o1[2], o2[2];
#pragma unroll
                for (int e = 0; e < 2; ++e) { const int i = 2 * j + e;
                    const float y1 = (e ? bfhi(xw[j]) : bflo(xw[j])) * rstd * nw[i], y2 = (e ? bfhi(xw[16 + j]) : bflo(xw[16 + j])) * rstd * nw[i + 32];
                    const float ang = pf * INV_FREQ[i];
                    double rev = (double)ang * 0.15915494309189535; rev -= __builtin_rint(rev);
                    const float fr_ = (float)rev, sn = __builtin_amdgcn_sinf(fr_), cs = __builtin_amdgcn_cosf(fr_);
                    o1[e] = y1 * cs - y2 * sn; o2[e] = y2 * cs + y1 * sn; }
                xw[j] = cvt_pk_bf16(o1[0], o1[1]); xw[16 + j] = cvt_pk_bf16(o2[0], o2[1]);
            }
#pragma unroll
            for (int i = 0; i < 8; ++i) { u32x4 v; v.x = xw[4 * i]; v.y = xw[4 * i + 1]; v.z = xw[4 * i + 2]; v.w = xw[4 * i + 3]; *(LAS u32x4*)(rp + 8 * i) = v; }
        }
        __syncthreads();
        const float sink = sinks[hk * 4 + (w >> 1)];
#pragma unroll 1
        for (int qt = 0; qt < 2; ++qt) {
            const int qrow = 32 * w + 16 * qt + fr;
            bf16x8 qf[2];
#pragma unroll
            for (int ks = 0; ks < 2; ++ks) qf[ks] = *(const LAS bf16x8*)(Qs + qrow * 72 + 32 * ks + 8 * kq);
            f32x4 s[12];
#pragma unroll
            for (int t = 0; t < 12; ++t) { s[t] = (f32x4){0.f, 0.f, 0.f, 0.f};
                if (t < nkt) {
#pragma unroll
                    for (int ks = 0; ks < 2; ++ks) { const bf16x8 a = *(const LAS bf16x8*)(Ks + (16 * t + fr) * 72 + 32 * ks + 8 * kq); s[t] = MFMA16(a, qf[ks], s[t]); } } }
            float mx = sink;
#pragma unroll
            for (int t = 0; t < 12; ++t) if (t < nkt) {
#pragma unroll
                for (int e = 0; e < 4; ++e) { s[t][e] *= 0.125f; mx = fmaxf(mx, s[t][e]); } }
            mx = fmaxf(mx, shx(mx, lane, 16)); mx = fmaxf(mx, shx(mx, lane, 32));
            float sum = 0.f;
#pragma unroll
            for (int t = 0; t < 12; ++t) if (t < nkt) {
#pragma unroll
                for (int e = 0; e < 4; ++e) { const float p = fexp(s[t][e] - mx); s[t][e] = p; sum += p; } }
            sum += shx(sum, lane, 16); sum += shx(sum, lane, 32);
            const float inv = 1.0f / (sum + fexp(sink - mx));
            f32x4 o[4];
#pragma unroll
            for (int dt = 0; dt < 4; ++dt) o[dt] = (f32x4){0.f, 0.f, 0.f, 0.f};
#pragma unroll
            for (int k2 = 0; k2 < 6; ++k2) if (2 * k2 < nkt) {
                u32x4 pk; pk.x = cvt_pk_bf16(s[2 * k2][0], s[2 * k2][1]); pk.y = cvt_pk_bf16(s[2 * k2][2], s[2 * k2][3]);
                pk.z = cvt_pk_bf16(s[2 * k2 + 1][0], s[2 * k2 + 1][1]); pk.w = cvt_pk_bf16(s[2 * k2 + 1][2], s[2 * k2 + 1][3]);
                const bf16x8 pf = __builtin_bit_cast(bf16x8, pk);
#pragma unroll
                for (int dt = 0; dt < 4; ++dt) {
                    const LAS bf16_t* vp = Vt + (16 * dt + fr) * 200 + 32 * k2 + 4 * kq;
                    const bf16x4 lo = *(const LAS bf16x4*)vp, hi = *(const LAS bf16x4*)(vp + 16);
                    const bf16x8 a = __builtin_shufflevector(lo, hi, 0, 1, 2, 3, 4, 5, 6, 7);
                    o[dt] = MFMA16(a, pf, o[dt]); } }
            const int g = qrow >> 6, qi = qrow & 63;
            GAS bf16_t* op = PROJ + (size_t)(tq0 + qi) * PW + C_Q + (hk * 4 + g) * 64 + 4 * kq;
#pragma unroll
            for (int dt = 0; dt < 4; ++dt) { u32x2 wv; wv.x = cvt_pk_bf16(o[dt][0] * inv, o[dt][1] * inv); wv.y = cvt_pk_bf16(o[dt][2] * inv, o[dt][3] * inv);
                *(GAS u32x2*)(op + 16 * dt) = wv; }
        }
        unit = unit_next;
    }
#undef SWA_FETCH
}

__device__ __forceinline__ void mlstm_phase(int wid_s, LAS unsigned char* lds, GAS bf16_t* PROJ, const GAS bf16_t* KM, const GAS float* IF, GAS float* SSQ) {
    const int tid = opaque_tid(wid_s), w = __builtin_amdgcn_readfirstlane(tid >> 6), lane = tid & 63, fr = lane & 15, kq = lane >> 4;
    LAS bf16_t* Qs = (LAS bf16_t*)lds;
    LAS bf16_t* Ks = Qs + 64 * 264;
    LAS bf16_t* Ct = Ks + 64 * 264;
    LAS bf16_t* Vt = Ct + 80 * 264;
    LAS bf16_t* Vw = Vt + 80 * 72;
    LAS bf16_t* Sw = Vw + 80 * 72;
    LAS float* vec = (LAS float*)(Sw + 64 * 72);
    const int tt = w & 3, wh = w >> 2, ndv = wh ? 2 : 3, dv0 = wh ? 3 : 0, nh = wh ? 1 : 3;
    for (int unit = row_cu(opaque_bx(), gridDim.x); unit < 256; unit += gridDim.x) {
        const int bh = unit >> 2, dvq = unit & 3, b = bh >> 2, h = bh & 3;
        __syncthreads();
        for (int i = tid; i < 80 * 264 / 2; i += 512) ((LAS unsigned*)Ct)[i] = 0u;
        for (int i = tid; i < 16 * 72; i += 512) { Vt[64 * 72 + i] = (i < 64) ? (bf16_t)0x3f80 : (bf16_t)0; Vw[64 * 72 + i] = 0; }
        f32x4 Cacc[2][5];
#pragma unroll
        for (int i = 0; i < 2; ++i)
#pragma unroll
            for (int j = 0; j < 5; ++j) Cacc[i][j] = (f32x4){0.f, 0.f, 0.f, 0.f};
        float m = 0.f;
        u32x4 nq[4], nk[4], nv; float nli, nlf;
        const unsigned voq = (unsigned)(((tid >> 5) * PW + (tid & 31) * 8) * 2), vok = (unsigned)(((tid >> 5) * DM + (tid & 31) * 8) * 2);
        const unsigned vov = (unsigned)(((tid >> 3) * PW + (tid & 7) * 8) * 2), voi = (unsigned)lane * 32u;
#define MLSTM_FETCH(t1) do { \
          const GAS char* qb_ = (const GAS char*)(PROJ + (size_t)(t1) * PW + C_U + h * 256); const GAS char* kb_ = (const GAS char*)(KM + (size_t)(t1) * DM + h * 256); \
          const GAS char* vb_ = (const GAS char*)(PROJ + (size_t)(t1) * PW + C_V + h * 256 + dvq * 64); const GAS char* ib_ = (const GAS char*)(IF + (size_t)(t1) * 8 + h); \
          nli = *(const GAS float*)(ib_ + voi); nlf = *(const GAS float*)(ib_ + 16 + voi); \
          _Pragma("unroll") for (int i = 0; i < 4; ++i) { nq[i] = *(const GAS u32x4*)(qb_ + (size_t)i * 16 * PW * 2 + voq); nk[i] = *(const GAS u32x4*)(kb_ + (size_t)i * 16 * DM * 2 + vok); } \
          nv = *(const GAS u32x4*)(vb_ + vov); } while (0)
        MLSTM_FETCH(b * SEQ);
        f32x4 num[3];
#define MLSTM_OUT(t_out, vc_out) do { \
                const f32x4 den4 = *(const LAS f32x4*)((vc_out) + 192 + 16 * tt + 4 * kq), b4 = *(const LAS f32x4*)((vc_out) + 128 + 16 * tt + 4 * kq), Mo4 = *(const LAS f32x4*)((vc_out) + 64 + 16 * tt + 4 * kq); \
                float dd[4], ss[4]; \
                _Pragma("unroll") for (int e = 0; e < 4; ++e) { dd[e] = 1.0f / fmaxf(fabsf(den4[e]), fexp(-(b4[e] + Mo4[e]))); ss[e] = 0.f; } \
                _Pragma("unroll") for (int j = 0; j < 3; ++j) if (j < nh) { \
                    _Pragma("unroll") for (int e = 0; e < 4; ++e) { const float hv = num[j][e] * dd[e]; ss[e] += hv * hv; \
                        PROJ[(size_t)((t_out) + 16 * tt + 4 * kq + e) * PW + C_V + h * 256 + dvq * 64 + 16 * (dv0 + j) + fr] = f2bf(hv); } } \
                _Pragma("unroll") for (int e = 0; e < 4; ++e) { float v = ss[e]; \
                    v += DPP_F(v, v, 0x128, 0xf); v += DPP_F(v, v, 0x124, 0xf); v += DPP_F(v, v, 0x122, 0xf); v += DPP_F(v, v, 0x121, 0xf); \
                    if (fr == 0) __hip_atomic_fetch_add(SSQ + (size_t)((t_out) + 16 * tt + 4 * kq + e) * 4 + h, v, __ATOMIC_RELAXED, __HIP_MEMORY_SCOPE_AGENT); } } while (0)
#pragma unroll 1
        for (int c = 0; c < 32; ++c) {
            const int t0 = b * SEQ + c * 64;
            LAS float* vc = vec + (c & 1) * 256;
            const float li = nli, lf = nlf;
            const float bcs = scan_sum64(lf);
            const float uu = li - bcs;
            const float cm = scan_max64(uu);
            const float Mv = fmaxf(m, cm);
            const float b63 = __int_as_float(__builtin_amdgcn_readlane(__float_as_int(bcs), 63)), cm63 = __int_as_float(__builtin_amdgcn_readlane(__float_as_int(cm), 63)), Mend = fmaxf(m, cm63);
            const float wg = fexp(uu - Mend), decay = fexp(m - Mend), m_old = m;
            m = b63 + Mend;
            if (w == 0) { vc[lane] = uu; vc[64 + lane] = Mv; vc[128 + lane] = bcs; Vw[64 * 72 + lane] = f2bf(wg); }
#pragma unroll
            for (int i = 0; i < 4; ++i) { const int p = tid + 512 * i, r = p >> 5, pc = p & 31;
                *(LAS u32x4*)(Qs + r * 264 + pc * 8) = nq[i];
                *(LAS u32x4*)(Ks + r * 264 + pc * 8) = nk[i]; }
            { const int r = tid >> 3, pc = tid & 7;
              const float wgr = shi(wg, r & 63);
              const unsigned vs[4] = {nv.x, nv.y, nv.z, nv.w};
#pragma unroll
              for (int e = 0; e < 4; ++e) { const int d = pc * 8 + 2 * e;
                  Vt[d * 72 + r] = (bf16_t)(vs[e] & 0xffffu); Vt[(d + 1) * 72 + r] = (bf16_t)(vs[e] >> 16);
                  Vw[d * 72 + r] = f2bf(bflo(vs[e]) * wgr); Vw[(d + 1) * 72 + r] = f2bf(bfhi(vs[e]) * wgr); } }
            if (c + 1 < 32) MLSTM_FETCH(t0 + 64);
            if (c > 0) MLSTM_OUT(t0 - 64, vec + ((c - 1) & 1) * 256);
            __syncthreads();
            bf16x8 qfr[8];
#pragma unroll
            for (int ks = 0; ks < 8; ++ks) qfr[ks] = *(const LAS bf16x8*)(Qs + (16 * tt + fr) * 264 + 32 * ks + 8 * kq);
            {
                const int t = 16 * tt + fr; const float Mt = vc[64 + t];
#pragma unroll
                for (int si = 0; si < 2; ++si) { const int st = 2 * wh + si; f32x4 sa = (f32x4){0.f, 0.f, 0.f, 0.f};
                    if (st <= tt) {
#pragma unroll
                        for (int ks = 0; ks < 8; ++ks) { const bf16x8 a = *(const LAS bf16x8*)(Ks + (16 * st + fr) * 264 + 32 * ks + 8 * kq); sa = MFMA16(a, qfr[ks], sa); } }
                    const f32x4 u4 = *(const LAS f32x4*)(vc + 16 * st + 4 * kq);
#pragma unroll
                    for (int e = 0; e < 4; ++e) { const int s = 16 * st + 4 * kq + e; const float wgt = (s <= t) ? fexp(u4[e] - Mt) : 0.f; sa[e] *= wgt; }
                    u32x2 pk; pk.x = cvt_pk_bf16(sa[0], sa[1]); pk.y = cvt_pk_bf16(sa[2], sa[3]);
                    *(LAS u32x2*)(Sw + t * 72 + 16 * st + 4 * kq) = pk; }
            }
#pragma unroll
            for (int j = 0; j < 3; ++j) num[j] = (f32x4){0.f, 0.f, 0.f, 0.f};
#pragma unroll
            for (int ks = 0; ks < 8; ++ks) { const bf16x8 aq = qfr[ks];
#pragma unroll
                for (int j = 0; j < 3; ++j) if (j < ndv) { const bf16x8 bc = *(const LAS bf16x8*)(Ct + (16 * (dv0 + j) + fr) * 264 + 32 * ks + 8 * kq); num[j] = MFMA16(aq, bc, num[j]); } }
            const f32x4 M4 = *(const LAS f32x4*)(vc + 64 + 16 * tt + 4 * kq);
#pragma unroll
            for (int e = 0; e < 4; ++e) { const float wi = fexp(m_old - M4[e]);
#pragma unroll
                for (int j = 0; j < 3; ++j) num[j][e] *= wi; }
            __syncthreads();
#pragma unroll
            for (int ks = 0; ks < 2; ++ks) { const bf16x8 as = *(const LAS bf16x8*)(Sw + (16 * tt + fr) * 72 + 32 * ks + 8 * kq);
#pragma unroll
                for (int j = 0; j < 3; ++j) if (j < ndv) { const bf16x8 bv = *(const LAS bf16x8*)(Vt + (16 * (dv0 + j) + fr) * 72 + 32 * ks + 8 * kq); num[j] = MFMA16(as, bv, num[j]); } }
#pragma unroll
            for (int i = 0; i < 2; ++i)
#pragma unroll
                for (int j = 0; j < 5; ++j) Cacc[i][j] *= decay;
#pragma unroll
            for (int ks = 0; ks < 2; ++ks) {
                bf16x8 ak[2];
#pragma unroll
                for (int i = 0; i < 2; ++i) { const LAS bf16_t* kp = Ks + (32 * ks + 8 * kq) * 264 + 16 * (2 * w + i) + fr;
#pragma unroll
                    for (int e = 0; e < 8; ++e) ak[i][e] = (short)kp[e * 264]; }
#pragma unroll
                for (int j = 0; j < 5; ++j) { const bf16x8 bv = *(const LAS bf16x8*)(Vw + (16 * j + fr) * 72 + 32 * ks + 8 * kq);
#pragma unroll
                    for (int i = 0; i < 2; ++i) Cacc[i][j] = MFMA16(ak[i], bv, Cacc[i][j]); } }
            if (wh == 1 && fr == 0) *(LAS f32x4*)(vc + 192 + 16 * tt + 4 * kq) = num[1];
#pragma unroll
            for (int i = 0; i < 2; ++i)
#pragma unroll
                for (int j = 0; j < 5; ++j) { u32x2 pk; pk.x = cvt_pk_bf16(Cacc[i][j][0], Cacc[i][j][1]); pk.y = cvt_pk_bf16(Cacc[i][j][2], Cacc[i][j][3]);
                    *(LAS u32x2*)(Ct + (16 * j + fr) * 264 + 16 * (2 * w + i) + 4 * kq) = pk; }
            __syncthreads();
        }
        MLSTM_OUT(b * SEQ + 31 * 64, vec + 256);
    }
#undef MLSTM_OUT
}

__device__ __forceinline__ void fixup_phase(int wid_s, GAS bf16_t* PROJ, const GAS bf16_t* UA, const GAS float* SSQ, const GAS float* onorm, const GAS float* skip) {
    const int tid = opaque_tid(wid_s), cg8 = (tid & 127) * 8, rg = tid >> 7, hd = cg8 >> 8;
    float on[8], sk[8];
#pragma unroll
    for (int e = 0; e < 8; ++e) { on[e] = onorm[cg8 + e]; sk[e] = skip[cg8 + e]; }
    const int G_ = gridDim.x, rc_ = row_cu(opaque_bx(), G_), per_ = (G_ == 256) ? 2 : 1;
    for (int it_ = rc_ * per_; it_ < T / 64; it_ += (it_ % per_ == per_ - 1) ? (G_ * per_ - (per_ - 1)) : 1) {
        const int item = it_;
#pragma unroll 4
        for (int rr = 0; rr < 16; ++rr) {
            const size_t row = (size_t)item * 64 + rg * 16 + rr;
            const u32x4 hv = *(const GAS u32x4*)(PROJ + row * PW + C_V + cg8), ov = *(const GAS u32x4*)(PROJ + row * PW + C_O + cg8), uv = *(const GAS u32x4*)(UA + row * DM + cg8);
            const float rstd = 1.0f / sqrtf(SSQ[row * 4 + hd] * (1.0f / 256.0f) + EPS);
            const float hh[8] = {bflo(hv.x), bfhi(hv.x), bflo(hv.y), bfhi(hv.y), bflo(hv.z), bfhi(hv.z), bflo(hv.w), bfhi(hv.w)};
            const float oo[8] = {bflo(ov.x), bfhi(ov.x), bflo(ov.y), bfhi(ov.y), bflo(ov.z), bfhi(ov.z), bflo(ov.w), bfhi(ov.w)};
            const float ua[8] = {bflo(uv.x), bfhi(uv.x), bflo(uv.y), bfhi(uv.y), bflo(uv.z), bfhi(uv.z), bflo(uv.w), bfhi(uv.w)};
            float y[8];
#pragma unroll
            for (int e = 0; e < 8; ++e) y[e] = fsigmoid(oo[e]) * (hh[e] * rstd * on[e] + sk[e] * ua[e]);
            u32x4 wv; wv.x = cvt_pk_bf16(y[0], y[1]); wv.y = cvt_pk_bf16(y[2], y[3]); wv.z = cvt_pk_bf16(y[4], y[5]); wv.w = cvt_pk_bf16(y[6], y[7]);
            *(GAS u32x4*)(PROJ + row * PW + C_O + cg8) = wv;
        }
    }
}


#define XB_TMO      128
#define XB_XCNT(j)  (256  + 64 * (j))
#define XB_XSUB(j)  (1280 + 64 * (j))
#define XB_XGEN(j)  (2304 + 64 * (j))
#define XB_TOP      3328
#define XB_TOPGEN   3392
#define XCD_BAR_WORDS 3456
#define XB_SPIN_CAP (1u << 19)
__device__ __forceinline__ unsigned xb_ld(GAS unsigned* p)              { return __hip_atomic_load(p, __ATOMIC_RELAXED, __HIP_MEMORY_SCOPE_AGENT); }
__device__ __forceinline__ unsigned xb_add(GAS unsigned* p, unsigned v) { return __hip_atomic_fetch_add(p, v, __ATOMIC_RELAXED, __HIP_MEMORY_SCOPE_AGENT); }
__device__ __forceinline__ unsigned xb_xcc_id() { return (unsigned)__builtin_amdgcn_s_getreg((3 << 11) | 20) & 0xFu; }
#define XB_SPIN(cond, bar) do { unsigned _sp = 0; while (cond) { __builtin_amdgcn_s_sleep(1); \
    if ((++_sp & 255u) == 0u) { if (xb_ld(&(bar)[XB_TMO])) break; if (_sp > XB_SPIN_CAP) { xb_add(&(bar)[XB_TMO], 1u); break; } } } } while (0)
__device__ __forceinline__ void xcd_barrier_complete(GAS unsigned* bar, unsigned x, unsigned& nloc, unsigned& nx) {
    const unsigned G = gridDim.x;
    unsigned sum, cnt, mine, sp = 0u;
    for (;;) {
        sum = 0u; cnt = 0u; mine = 0u;
#pragma unroll
        for (unsigned j = 0; j < 16; ++j) { const unsigned c = xb_ld(&bar[XB_XCNT(j)]); sum += c; cnt += (c > 0u) ? 1u : 0u; mine = (j == x) ? c : mine; }
        if (sum == G) break;
        __builtin_amdgcn_s_sleep(1);
        if ((++sp & 255u) == 0u) { if (xb_ld(&bar[XB_TMO])) break; if (sp > XB_SPIN_CAP) { xb_add(&bar[XB_TMO], 1u); break; } }
    }
    nloc = mine > 0u ? mine : 1u; nx = cnt > 0u ? cnt : 1u;
}
__device__ __forceinline__ void grid_barrier(int wid_s, GAS unsigned* bar, volatile LAS unsigned* st) {
    const int tid = opaque_tid(wid_s);
    asm volatile("s_waitcnt vmcnt(0)" ::: "memory");
    __syncthreads();
    if (tid == 0) {
        __builtin_amdgcn_s_waitcnt(0);
        const unsigned x = xb_xcc_id();
        unsigned nloc = st[0], nx = st[1];
        if (nloc == 0u) { xcd_barrier_complete(bar, x, nloc, nx); st[0] = nloc; st[1] = nx; }
        const unsigned old = xb_add(&bar[XB_XSUB(x)], 1u);
        const unsigned gen = old / nloc;
        if (old + 1u == (gen + 1u) * nloc) {
            __builtin_amdgcn_fence(__ATOMIC_RELEASE, "agent");
            asm volatile("s_waitcnt vmcnt(0)" ::: "memory");
            const unsigned og = xb_add(&bar[XB_TOP], 1u);
            const unsigned tg = og / nx;
            if (og + 1u == (tg + 1u) * nx) xb_add(&bar[XB_TOPGEN], 1u);
            else XB_SPIN(xb_ld(&bar[XB_TOPGEN]) == tg, bar);
            __builtin_amdgcn_fence(__ATOMIC_ACQUIRE, "agent");
            xb_add(&bar[XB_XGEN(x)], 1u);
            asm volatile("s_waitcnt vmcnt(0)" ::: "memory");
        } else {
            XB_SPIN(xb_ld(&bar[XB_XGEN(x)]) == gen, bar);
            __builtin_amdgcn_fence(__ATOMIC_ACQUIRE, "agent");
            asm volatile("s_waitcnt vmcnt(0)" ::: "memory");
        }
    }
    __syncthreads();
}

#define XL_CNT(j) (3520 + 64 * (j))
#define XL_WORDS 4608
__device__ __forceinline__ void xcd_local_barrier(int wid_s, GAS unsigned* bar, volatile LAS unsigned* st) {
    const int tid = opaque_tid(wid_s);
    asm volatile("s_waitcnt vmcnt(0)" ::: "memory");
    __syncthreads();
    if (tid == 0) {
        const unsigned x = xb_xcc_id(), nloc = st[0];
        const unsigned old = xb_add(&bar[XL_CNT(x)], 1u), target = (old / nloc + 1u) * nloc;
        XB_SPIN(xb_ld(&bar[XL_CNT(x)]) < target, bar);
        __builtin_amdgcn_fence(__ATOMIC_ACQUIRE, "agent");
        asm volatile("s_waitcnt vmcnt(0)" ::: "memory");
    }
    __syncthreads();
}

typedef const __attribute__((address_space(4))) unsigned long long* kargp_t;
__device__ __forceinline__ unsigned long long ldarg(int i) { kargp_t kp = (kargp_t)__builtin_amdgcn_kernarg_segment_ptr(); asm volatile("" : "+s"(kp)); return kp[i]; }
#define PIN(i) ((const GAS float*)ldarg(i))
#define POUT ((GAS float*)ldarg(28))
#define WSP(off) ((GAS unsigned char*)ldarg(29) + (off))
#define WB(off) ((GAS bf16_t*)(((sidx & 1) ? WSP(WS_W) : ((GAS unsigned char*)ldarg(28) + 64 * MiB)) + (off)))
#define MODL(l) ((const GAS float*)WSP(WS_MOD) + (size_t)(l) * NB * 9216)

__global__ void __launch_bounds__(512, 2) mega_fwd(Params p) {
    extern __shared__ __attribute__((aligned(16))) unsigned char lds_raw[];
    LAS unsigned char* lds = (LAS unsigned char*)lds_raw;
    const int wid_s = __builtin_amdgcn_readfirstlane((int)(threadIdx.x >> 6));
    volatile LAS unsigned* bst = (volatile LAS unsigned*)(lds + LDS_BYTES - 16);
    { GAS unsigned* bar = (GAS unsigned*)WSP(0);
      if (threadIdx.x == 0) { *(volatile LAS int*)VBX_LDS_ADDR = (int)blockIdx.x; bst[0] = 0u; bst[1] = 0u; }
      if (blockIdx.x == 0) for (int i = threadIdx.x; i < XL_WORDS; i += 512) __hip_atomic_store(bar + i, 0u, __ATOMIC_RELAXED, __HIP_MEMORY_SCOPE_AGENT);
      __syncthreads();
      mod_phase(wid_s, lds, PIN(I_C), PIN(I_ADAW), PIN(I_ADAB), (GAS float*)WSP(WS_MOD));
      cg::this_grid().sync();
      const unsigned xcc = xb_xcc_id(); unsigned rank = 0u;
      if (threadIdx.x == 0) rank = xb_add(bar + XB_XCNT(xcc & 15u), 1u);
      grid_barrier(wid_s, bar, bst);
      if (threadIdx.x == 0) {
          bool ok = (gridDim.x == 256) && (xcc < 8u);
          for (int j = 0; j < 16; ++j) ok = ok && (xb_ld(bar + XB_XCNT(j)) == (j < 8 ? 32u : 0u));
          if (ok) *(volatile LAS int*)VBX_LDS_ADDR = (int)(xcc + 8u * rank);
          *(volatile LAS int*)(VBX_LDS_ADDR + 4u) = ok ? 1 : 0;
      }
      __syncthreads(); }
#define GRID_SYNC() grid_barrier(wid_s, (GAS unsigned*)WSP(0), bst)
#define XCD_SYNC() do { if (__builtin_amdgcn_readfirstlane(*(volatile LAS int*)(VBX_LDS_ADDR + 4u))) xcd_local_barrier(wid_s, (GAS unsigned*)WSP(0), bst); else grid_barrier(wid_s, (GAS unsigned*)WSP(0), bst); } while (0)

#pragma unroll 1
    for (int l = 0; l < 2; ++l) {
#pragma unroll 1
        for (int stage = 0; stage < 3; ++stage) {
            const int G = gridDim.x, bx = opaque_bx();
            const int sidx = l * 3 + stage;
            if (stage != 1) {
                const int f = stage >> 1;
                {
                    const int tid = opaque_tid(wid_s), wv = tid >> 6, lane = tid & 63, gw = bx * 8 + wv, NGW = G * 8;
                    LAS float* cscr = (LAS float*)(lds + 32768 + wv * 8448);
                    const bool first = (l == 0 && stage == 0), last = (l == 1 && stage == 2);
                    const GAS void* xin = first ? (const GAS void*)PIN(I_X) : (const GAS void*)POUT;
                    modulate_phase<false>(wid_s, lds, xin, first ? 1 : 0, last ? (GAS bf16_t*)WSP(WS_UA) : (GAS bf16_t*)nullptr, PIN(f ? I_F2N : I_F1N) + l * DM, MODL(l), f ? 6 : 0, (GAS bf16_t*)WSP(WS_H), nullptr, nullptr, nullptr, nullptr);
                    int base = 0;
                    CvtJob j1{PIN(f ? I_F2WI : I_F1WI) + (size_t)l * DM * 2 * FF, 2 * FF, DM, 2 * FF, WB(W_F1), 2, 1.0f}; cvt_run(j1, base, gw, NGW, cscr, lane);
                    CvtJob j2{PIN(f ? I_F2WO : I_F1WO) + (size_t)l * FF * DM, DM, FF, DM, WB(W_F2), 0, 1.0f}; cvt_run(j2, base, gw, NGW, cscr, lane);
                }
                GRID_SYNC();
                { pg8::Gemm g{(GAS bf16_t*)WSP(WS_H), WB(W_F1), T, 2 * FF, DM, DM, DM, 1 << 30, 0}; pg8::StaticOrder S; S.init(T, 2 * FF, G, bx);
                  pg8::EpiSwiGLU E{(GAS bf16_t*)WSP(WS_PROJ), FF}; pg8::gemm_phase(wid_s, lds, g, S, E); }
                XCD_SYNC();
                { pg8::Gemm g{(GAS bf16_t*)WSP(WS_PROJ), WB(W_F2), T, DM, FF, FF, FF, 1 << 30, 0}; pg8::StaticOrder S; S.init(T, DM, G, bx);
                  const bool first = (l == 0 && stage == 0), last = (l == 1 && stage == 2);
                  const GAS void* xin = first ? (const GAS void*)PIN(I_X) : (last ? (const GAS void*)WSP(WS_UA) : (const GAS void*)POUT);
                  pg8::EpiRes E{xin, (GAS void*)POUT, MODL(l) + (f ? 8 : 2) * 1024, 9216, 0.5f, first ? 1 : 0, last ? 1 : 0}; pg8::gemm_phase(wid_s, lds, g, S, E); }
                XCD_SYNC();
            } else {
                {
                    const int tid = opaque_tid(wid_s), wv = tid >> 6, lane = tid & 63, gw = bx * 8 + wv, NGW = G * 8;
                    LAS float* cscr = (LAS float*)(lds + 32768 + wv * 8448);
                    const GAS float* mixw = PIN(I_MIXW) + (size_t)l * DM * NIN;
                    modulate_phase<true>(wid_s, lds, (const GAS void*)POUT, 0, (GAS bf16_t*)nullptr, PIN(I_MIXN) + l * DM, MODL(l), 3, (GAS bf16_t*)WSP(WS_H), mixw, PIN(I_GATEB) + l * 8, (GAS float*)WSP(WS_IF), (GAS float*)WSP(WS_SSQ));
                    int base = 0;
                    CvtJob j1{mixw, NIN, DM, PW, WB(W_MIX), 1, 1.0f}; cvt_run(j1, base, gw, NGW, cscr, lane);
                    CvtJob j2{PIN(I_MERGEW) + (size_t)l * DM * 2 * DM, 2 * DM, DM, 2 * DM, WB(W_MERGE), 0, -1.4426950408889634f}; cvt_run(j2, base, gw, NGW, cscr, lane);
                    CvtJob j3{PIN(I_PA) + (size_t)l * DM * DM, DM, DM, DM, WB(W_PA), 0, 1.0f}; cvt_run(j3, base, gw, NGW, cscr, lane);
                    CvtJob j4{PIN(I_PB) + (size_t)l * DM * DM, DM, DM, DM, WB(W_PB), 0, 1.0f}; cvt_run(j4, base, gw, NGW, cscr, lane);
                    CvtJob j5{PIN(I_WOUT) + (size_t)l * DM * DM, DM, DM, DM, WB(W_WO), 0, 1.0f}; cvt_run(j5, base, gw, NGW, cscr, lane);
#pragma unroll 1
                    for (int hd = 0; hd < 4; ++hd) {
                        CvtJob jq{PIN(I_WQ) + ((size_t)l * 4 + hd) * 65536, 256, 256, 256, WB(W_QK) + (size_t)hd * 512 * 256, 0, 1.0f}; cvt_run(jq, base, gw, NGW, cscr, lane);
                        CvtJob jk{PIN(I_WK) + ((size_t)l * 4 + hd) * 65536, 256, 256, 256, WB(W_QK) + (size_t)hd * 512 * 256 + 256 * 256, 0, 0.0625f}; cvt_run(jk, base, gw, NGW, cscr, lane);
                    }
                }
                GRID_SYNC();
                { pg8::Gemm g{(GAS bf16_t*)WSP(WS_H), WB(W_MIX), T, PW, DM, DM, DM, 1 << 30, 0}; pg8::StaticOrder S; S.init(T, PW, G, bx);
                  GAS bf16_t* PROJ = (GAS bf16_t*)WSP(WS_PROJ);
                  pg8::EpiStore2 E{PROJ, PW, PROJ, PW, 1 << 30, nullptr, 0}; pg8::gemm_phase(wid_s, lds, g, S, E); }
                XCD_SYNC();
                conv_phase(wid_s, (GAS bf16_t*)WSP(WS_PROJ), PIN(I_CONVW) + l * 4 * DM, PIN(I_CONVB) + l * DM, (GAS bf16_t*)WSP(WS_UA));
                swa_phase(wid_s, lds, (GAS bf16_t*)WSP(WS_PROJ), (const GAS int*)PIN(I_POS), PIN(I_QN) + l * 64, PIN(I_KN) + l * 64, PIN(I_SINK) + l * 16);
                XCD_SYNC();
                { pg8::Gemm g{(GAS bf16_t*)WSP(WS_UA), WB(W_QK), T, 2048, 256, DM, 256, 2, 512}; pg8::StaticOrder S; S.init(T, 2048, G, bx);
                  pg8::EpiQK E{(GAS bf16_t*)WSP(WS_PROJ) + C_U, PW, (GAS bf16_t*)WSP(WS_KM), DM}; pg8::gemm_phase(wid_s, lds, g, S, E); }
                XCD_SYNC();
                mlstm_phase(wid_s, lds, (GAS bf16_t*)WSP(WS_PROJ), (GAS bf16_t*)WSP(WS_KM), (const GAS float*)WSP(WS_IF), (GAS float*)WSP(WS_SSQ));
                XCD_SYNC();
                fixup_phase(wid_s, (GAS bf16_t*)WSP(WS_PROJ), (GAS bf16_t*)WSP(WS_UA), (const GAS float*)WSP(WS_SSQ), PIN(I_ONORM) + l * DM, PIN(I_SKIP) + l * DM);
                { pg8::Gemm g{(GAS bf16_t*)WSP(WS_H), WB(W_MERGE), T, 2 * DM, DM, DM, DM, 1 << 30, 0}; pg8::StaticOrder S; S.init(T, 2 * DM, G, bx);
                  pg8::EpiStore2 E{(GAS bf16_t*)WSP(WS_PROJ) + C_U, PW, (GAS bf16_t*)WSP(WS_KM), DM, 4, PIN(I_MERGEB) + l * 2 * DM, 1}; pg8::gemm_phase(wid_s, lds, g, S, E); }
                XCD_SYNC();
                { pg8::Gemm g{(GAS bf16_t*)WSP(WS_PROJ) + C_O, WB(W_PA), T, DM, DM, PW, DM, 1 << 30, 0}; pg8::StaticOrder S; S.init(T, DM, G, bx);
                  pg8::EpiGate<0> E{(GAS bf16_t*)WSP(WS_H), DM, (GAS bf16_t*)WSP(WS_PROJ) + C_U, PW}; pg8::gemm_phase(wid_s, lds, g, S, E); }
                { pg8::Gemm g{(GAS bf16_t*)WSP(WS_PROJ) + C_Q, WB(W_PB), T, DM, DM, PW, DM, 1 << 30, 0}; pg8::StaticOrder S; S.init(T, DM, G, bx);
                  pg8::EpiGate<1> E{(GAS bf16_t*)WSP(WS_H), DM, (GAS bf16_t*)WSP(WS_KM), DM}; pg8::gemm_phase(wid_s, lds, g, S, E); }
                XCD_SYNC();
                { pg8::Gemm g{(GAS bf16_t*)WSP(WS_H), WB(W_WO), T, DM, DM, DM, DM, 1 << 30, 0}; pg8::StaticOrder S; S.init(T, DM, G, bx);
                  pg8::EpiRes E{(const GAS void*)POUT, (GAS void*)POUT, MODL(l) + 5 * 1024, 9216, 1.0f, 0, 0}; pg8::gemm_phase(wid_s, lds, g, S, E); }
                XCD_SYNC();
            }
            if (l == STOP_L && stage == STOP_STAGE) return;
        }
    }
}

extern "C" void kernel_launch(void* const* d_in, const int* in_sizes, int n_in, void* d_out, int out_size, void* d_ws, size_t ws_size, hipStream_t stream) {
    static int grid = 0;
    if (grid == 0) {
        if (n_in != 28 || out_size != T * DM || ws_size < WS_END) { fprintf(stderr, "kernel_launch: unexpected problem (n_in %d, out %d, ws %zu)\n", n_in, out_size, ws_size); grid = -1; return; }
        int dev = 0, cus = 0, per_cu = 0;
        hipGetDevice(&dev);
        hipDeviceGetAttribute(&cus, hipDeviceAttributeMultiprocessorCount, dev);
        hipFuncSetAttribute((const void*)mega_fwd, hipFuncAttributeMaxDynamicSharedMemorySize, LDS_BYTES);
        if (hipOccupancyMaxActiveBlocksPerMultiprocessor(&per_cu, (const void*)mega_fwd, 512, LDS_BYTES) != hipSuccess || per_cu < 1) per_cu = 1;
        (void)hipGetLastError();
        grid = cus * per_cu;
        if (grid < 1) grid = 256;
    }
    if (grid < 0) return;
    Params p{};
    for (int i = 0; i < 28; ++i) p.in[i] = (const float*)d_in[i];
    p.out = (float*)d_out; p.ws = (unsigned char*)d_ws;
    void* args[] = {&p};
    hipError_t e = hipLaunchCooperativeKernel((const void*)mega_fwd, dim3(grid), dim3(512), args, LDS_BYTES, stream);
    if (e != hipSuccess) fprintf(stderr, "cooperative launch failed: %s (grid %d)\n", hipGetErrorString(e), grid);
}
```

```cpp
#include <hip/hip_runtime.h>
#include <hip/hip_cooperative_groups.h>
#include <cstdio>
#include <cstdint>
namespace cg = cooperative_groups;

#define LAS __attribute__((address_space(3)))
#define GAS __attribute__((address_space(1)))
typedef unsigned short bf16_t;
typedef short bf16x8 __attribute__((ext_vector_type(8)));
typedef short bf16x4 __attribute__((ext_vector_type(4)));
typedef float f32x4 __attribute__((ext_vector_type(4)));
typedef float f32x2 __attribute__((ext_vector_type(2)));
typedef unsigned u32x4 __attribute__((ext_vector_type(4)));
typedef unsigned u32x2 __attribute__((ext_vector_type(2)));

constexpr int DM = 1024, NB = 16, SEQ = 2048, T = NB * SEQ, FF = 2816, NIN = 4616;
constexpr int PW = 4608;
constexpr int C_U = 0, C_V = 1024, C_O = 2048, C_Q = 3072, C_K = 4096, C_VA = 4352;
constexpr float EPS = 1e-6f;
constexpr size_t MiB = 1u << 20;
constexpr size_t WS_MOD = 64 * 1024, WS_IF = 2 * MiB, WS_SSQ = 3 * MiB, WS_W = 4 * MiB, WS_H = 24 * MiB, WS_UA = 88 * MiB, WS_KM = 152 * MiB, WS_PROJ = 216 * MiB, WS_END = 504 * MiB;
constexpr size_t W_MIX = 0, W_MERGE = 9 * MiB, W_PA = 13 * MiB, W_PB = 15 * MiB, W_WO = 17 * MiB, W_QK = 19 * MiB;
constexpr size_t W_F1 = 0, W_F2 = 11 * MiB;
constexpr int LDS_BYTES = 147456;
#ifndef STOP_L
#define STOP_L 9
#endif
#ifndef STOP_STAGE
#define STOP_STAGE 9
#endif

__device__ __forceinline__ int opaque_tid(int wid_s) { int t; asm volatile("v_mbcnt_lo_u32_b32 %0, -1, 0\n\tv_mbcnt_hi_u32_b32 %0, -1, %0\n\tv_lshl_or_b32 %0, %1, 6, %0" : "=&v"(t) : "s"(wid_s)); return t; }
#define VBX_LDS_ADDR 147448u
__device__ __forceinline__ int opaque_bx() { int b = *(volatile LAS int*)VBX_LDS_ADDR; b = __builtin_amdgcn_readfirstlane(b); asm volatile("" : "+s"(b)); return b; }
__device__ __forceinline__ int row_cu(int c, int G) { return (G == 256) ? ((c & 7) * 32 + (c >> 3)) : c; }
typedef __bf16 bf16x2_t __attribute__((ext_vector_type(2)));
__device__ __forceinline__ unsigned cvt_pk_bf16(float lo, float hi) { const f32x2 v = {lo, hi}; return __builtin_bit_cast(unsigned, __builtin_convertvector(v, bf16x2_t)); }
__device__ __forceinline__ float bf2f(bf16_t x) { return __uint_as_float((unsigned)x << 16); }
__device__ __forceinline__ float bflo(unsigned x) { return __uint_as_float(x << 16); }
__device__ __forceinline__ float bfhi(unsigned x) { return __uint_as_float(x & 0xffff0000u); }
__device__ __forceinline__ bf16_t f2bf(float f) { return (bf16_t)(cvt_pk_bf16(f, 0.f) & 0xffffu); }
__device__ __forceinline__ float fexp(float x) { return __builtin_amdgcn_exp2f(x * 1.44269504088896f); }
__device__ __forceinline__ float fsigmoid(float x) { return __builtin_amdgcn_rcpf(1.0f + fexp(-x)); }
__device__ __forceinline__ float fsilu(float x) { return x * fsigmoid(x); }
__device__ __forceinline__ float shx(float v, int lane, int o) { return __int_as_float(__builtin_amdgcn_ds_bpermute((lane ^ o) << 2, __float_as_int(v))); }
__device__ __forceinline__ float shi(float v, int idx) { return __int_as_float(__builtin_amdgcn_ds_bpermute(idx << 2, __float_as_int(v))); }
__device__ __forceinline__ float wave_sum(float v, int lane) {
#pragma unroll
    for (int o = 1; o < 64; o <<= 1) v += shx(v, lane, o);
    return v;
}
#define DPP_F(old_, src_, ctrl_, rm_) __int_as_float(__builtin_amdgcn_update_dpp(__float_as_int(old_), __float_as_int(src_), (ctrl_), (rm_), 0xf, false))
__device__ __forceinline__ float scan_sum64(float v) {
    v += DPP_F(0.f, v, 0x111, 0xf); v += DPP_F(0.f, v, 0x112, 0xf); v += DPP_F(0.f, v, 0x114, 0xf); v += DPP_F(0.f, v, 0x118, 0xf);
    v += DPP_F(0.f, v, 0x142, 0xa); v += DPP_F(0.f, v, 0x143, 0xc); return v; }
__device__ __forceinline__ float scan_max64(float v) {
    const float ninf = -__builtin_inff();
    v = fmaxf(v, DPP_F(ninf, v, 0x111, 0xf)); v = fmaxf(v, DPP_F(ninf, v, 0x112, 0xf)); v = fmaxf(v, DPP_F(ninf, v, 0x114, 0xf)); v = fmaxf(v, DPP_F(ninf, v, 0x118, 0xf));
    v = fmaxf(v, DPP_F(ninf, v, 0x142, 0xa)); v = fmaxf(v, DPP_F(ninf, v, 0x143, 0xc)); return v; }
__device__ const float INV_FREQ[32] = {
1.0000000000e+00f, 7.4989420933e-01f, 5.6234132519e-01f, 4.2169650343e-01f, 3.1622776602e-01f, 2.3713737057e-01f, 1.7782794100e-01f, 1.3335214322e-01f,
1.0000000000e-01f, 7.4989420933e-02f, 5.6234132519e-02f, 4.2169650343e-02f, 3.1622776602e-02f, 2.3713737057e-02f, 1.7782794100e-02f, 1.3335214322e-02f,
1.0000000000e-02f, 7.4989420933e-03f, 5.6234132519e-03f, 4.2169650343e-03f, 3.1622776602e-03f, 2.3713737057e-03f, 1.7782794100e-03f, 1.3335214322e-03f,
1.0000000000e-03f, 7.4989420933e-04f, 5.6234132519e-04f, 4.2169650343e-04f, 3.1622776602e-04f, 2.3713737057e-04f, 1.7782794100e-04f, 1.3335214322e-04f};
#define MFMA16(a, b, c) __builtin_amdgcn_mfma_f32_16x16x32_bf16((a), (b), (c), 0, 0, 0)

namespace pg8 {
constexpr int BM = 256, BK = 64, HALF = 128, HTB = HALF * BK * 2, STAGE_BYTES = 8 * HTB, NXCD = 8, WGM = 8;
__host__ __device__ __forceinline__ int lds_byte(int r, int c) { const int st = (r >> 4) * 2 + (c >> 5), rr = r & 15, cc = c & 31, ob = rr * 64 + cc * 2; return st * 1024 + (ob ^ (((ob >> 9) & 1) << 5)); }
__host__ __device__ __forceinline__ void stage_rc(int b, int& R, int& C) { const int st = b / 1024, sb = b % 1024, swz = sb ^ (((sb >> 9) & 1) << 5); R = (st >> 1) * 16 + swz / 64; C = (st & 1) * 32 + (swz % 64) / 2; }
__host__ __device__ __forceinline__ int perm32(int rho) { const int n = rho >> 4, i = rho & 15; return 8 * (i >> 2) + 4 * n + (i & 3); }

struct Unit { int pm, pn; };
struct Gemm { const GAS bf16_t* A; const GAS bf16_t* Bt; int M, N, K, lda, ldb, agrp; size_t agoff; };

struct StaticOrder {
    int nM, nN, nwg, G, c;
    __host__ __device__ void init(int M, int N, int G_, int c_) { nM = M / BM; nN = N / BM; nwg = nM * nN; G = G_; c = c_; }
    __host__ __device__ bool next(int i, Unit& u) const {
        const long L = (long)i * G + c; if (L >= nwg) return false;
        int wgid = (int)L; { const int q = nwg / NXCD, r = nwg % NXCD, xcd = wgid % NXCD, off = wgid / NXCD; wgid = (xcd < r ? xcd * (q + 1) : r * (q + 1) + (xcd - r) * q) + off; }
        const int nig = WGM * nN, gid = wgid / nig, fm = gid * WGM, gsz = (nM - fm) < WGM ? (nM - fm) : WGM;
        u.pm = fm + ((wgid % nig) % gsz); u.pn = (wgid % nig) / gsz; return true;
    }
};

typedef f32x4 AccT[2][2][4][2];

struct EpiStore2 {
    static constexpr bool PERM = true;
    GAS bf16_t* O0; int ld0; GAS bf16_t* O1; int ld1; int split; const GAS float* bias; int act;
    __device__ __forceinline__ void operator()(const AccT& acc, const Unit& u, int wr, int wc, int fr, int fq) const {
        const int row0 = u.pm * BM + wr * 64 + fr;
        GAS bf16_t* base; int ld, ct;
        if (u.pn < split) { base = O0; ld = ld0; ct = u.pn; } else { base = O1; ld = ld1; ct = u.pn - split; }
        const int col0 = ct * BM + wc * 32 + 8 * fq, bcol0 = u.pn * BM + wc * 32 + 8 * fq;
#pragma unroll
        for (int bj = 0; bj < 2; ++bj) {
            f32x4 b0 = (f32x4){0.f, 0.f, 0.f, 0.f}, b1 = b0;
            if (act) { b0 = *(const GAS f32x4*)(bias + bcol0 + bj * HALF) * -1.4426950408889634f; b1 = *(const GAS f32x4*)(bias + bcol0 + bj * HALF + 4) * -1.4426950408889634f; }
#pragma unroll
            for (int ai = 0; ai < 2; ++ai)
#pragma unroll
                for (int m = 0; m < 4; ++m) {
                    f32x4 v0 = acc[ai][bj][m][0], v1 = acc[ai][bj][m][1];
                    if (act) { v0 += b0; v1 += b1;
#pragma unroll
                        for (int e = 0; e < 4; ++e) { v0[e] = __builtin_amdgcn_rcpf(1.0f + __builtin_amdgcn_exp2f(v0[e])); v1[e] = __builtin_amdgcn_rcpf(1.0f + __builtin_amdgcn_exp2f(v1[e])); } }
                    u32x4 w; w.x = cvt_pk_bf16(v0[0], v0[1]); w.y = cvt_pk_bf16(v0[2], v0[3]); w.z = cvt_pk_bf16(v1[0], v1[1]); w.w = cvt_pk_bf16(v1[2], v1[3]);
                    *(GAS u32x4*)(base + (size_t)(row0 + ai * HALF + m * 16) * ld + col0 + bj * HALF) = w;
                }
        }
    }
};
struct EpiQK {
    static constexpr bool PERM = true;
    GAS bf16_t* O0; int ld0; GAS bf16_t* O1; int ld1;
    __device__ __forceinline__ void operator()(const AccT& acc, const Unit& u, int wr, int wc, int fr, int fq) const {
        const int row0 = u.pm * BM + wr * 64 + fr, hd = u.pn >> 1;
        GAS bf16_t* base = (u.pn & 1) ? O1 : O0; const int ld = (u.pn & 1) ? ld1 : ld0;
        const int col0 = hd * BM + wc * 32 + 8 * fq;
#pragma unroll
        for (int bj = 0; bj < 2; ++bj)
#pragma unroll
            for (int ai = 0; ai < 2; ++ai)
#pragma unroll
                for (int m = 0; m < 4; ++m) {
                    const f32x4 v0 = acc[ai][bj][m][0], v1 = acc[ai][bj][m][1];
                    u32x4 w; w.x = cvt_pk_bf16(v0[0], v0[1]); w.y = cvt_pk_bf16(v0[2], v0[3]); w.z = cvt_pk_bf16(v1[0], v1[1]); w.w = cvt_pk_bf16(v1[2], v1[3]);
                    *(GAS u32x4*)(base + (size_t)(row0 + ai * HALF + m * 16) * ld + col0 + bj * HALF) = w;
                }
    }
};
struct EpiSwiGLU {
    static constexpr bool PERM = true;
    GAS bf16_t* O; int ldc;
    __device__ __forceinline__ void operator()(const AccT& acc, const Unit& u, int wr, int wc, int fr, int fq) const {
        const int row0 = u.pm * BM + wr * 64 + fr, col0 = u.pn * 128 + wc * 32 + 8 * fq;
#pragma unroll
        for (int ai = 0; ai < 2; ++ai)
#pragma unroll
            for (int m = 0; m < 4; ++m) {
                const f32x4 a0 = acc[ai][0][m][0], a1 = acc[ai][0][m][1], g0 = acc[ai][1][m][0], g1 = acc[ai][1][m][1];
                f32x4 r0, r1;
#pragma unroll
                for (int e = 0; e < 4; ++e) { r0[e] = a0[e] * g0[e] * __builtin_amdgcn_rcpf(1.0f + __builtin_amdgcn_exp2f(a0[e])); r1[e] = a1[e] * g1[e] * __builtin_amdgcn_rcpf(1.0f + __builtin_amdgcn_exp2f(a1[e])); }
                u32x4 w; w.x = cvt_pk_bf16(r0[0], r0[1]); w.y = cvt_pk_bf16(r0[2], r0[3]); w.z = cvt_pk_bf16(r1[0], r1[1]); w.w = cvt_pk_bf16(r1[2], r1[3]);
                *(GAS u32x4*)(O + (size_t)(row0 + ai * HALF + m * 16) * ldc + col0) = w;
            }
    }
};
template <int MODE> struct EpiGate {
    static constexpr bool PERM = true;
    GAS bf16_t* O; int ldo; const GAS bf16_t* Gt; int ldg;
    __device__ __forceinline__ void operator()(const AccT& acc, const Unit& u, int wr, int wc, int fr, int fq) const {
        const int row0 = u.pm * BM + wr * 64 + fr, col0 = u.pn * BM + wc * 32 + 8 * fq;
#pragma unroll
        for (int bj = 0; bj < 2; ++bj)
#pragma unroll
            for (int ai = 0; ai < 2; ++ai)
#pragma unroll
                for (int m = 0; m < 4; ++m) {
                    const size_t r = (size_t)(row0 + ai * HALF + m * 16);
                    const u32x4 gv = *(const GAS u32x4*)(Gt + r * ldg + col0 + bj * HALF);
                    GAS bf16_t* op = O + r * ldo + col0 + bj * HALF;
                    f32x4 v0 = acc[ai][bj][m][0], v1 = acc[ai][bj][m][1];
                    v0[0] *= bflo(gv.x); v0[1] *= bfhi(gv.x); v0[2] *= bflo(gv.y); v0[3] *= bfhi(gv.y);
                    v1[0] *= bflo(gv.z); v1[1] *= bfhi(gv.z); v1[2] *= bflo(gv.w); v1[3] *= bfhi(gv.w);
                    if (MODE == 1) { const u32x4 tv = *(const GAS u32x4*)op;
                        v0[0] += bflo(tv.x); v0[1] += bfhi(tv.x); v0[2] += bflo(tv.y); v0[3] += bfhi(tv.y);
                        v1[0] += bflo(tv.z); v1[1] += bfhi(tv.z); v1[2] += bflo(tv.w); v1[3] += bfhi(tv.w); }
                    u32x4 w; w.x = cvt_pk_bf16(v0[0], v0[1]); w.y = cvt_pk_bf16(v0[2], v0[3]); w.z = cvt_pk_bf16(v1[0], v1[1]); w.w = cvt_pk_bf16(v1[2], v1[3]);
                    *(GAS u32x4*)op = w;
                }
    }
};
struct EpiRes {
    static constexpr bool PERM = true;
    const GAS void* xin; GAS void* out; const GAS float* gate; int gstride; float scale; int in_f32, out_f32;
    __device__ __forceinline__ void operator()(const AccT& acc, const Unit& u, int wr, int wc, int fr, int fq) const {
        const int row0 = u.pm * BM + wr * 64 + fr, col0 = u.pn * BM + wc * 32 + 8 * fq;
        const GAS float* gp = gate + (size_t)(u.pm >> 3) * gstride;
#pragma unroll
        for (int bj = 0; bj < 2; ++bj) {
            const f32x4 g0 = *(const GAS f32x4*)(gp + col0 + bj * HALF) * scale, g1 = *(const GAS f32x4*)(gp + col0 + bj * HALF + 4) * scale;
#pragma unroll
            for (int ai = 0; ai < 2; ++ai)
#pragma unroll
                for (int m = 0; m < 4; ++m) {
                    const size_t off = (size_t)(row0 + ai * HALF + m * 16) * DM + col0 + bj * HALF;
                    f32x4 x0, x1;
                    if (in_f32) { x0 = *(const GAS f32x4*)((const GAS float*)xin + off); x1 = *(const GAS f32x4*)((const GAS float*)xin + off + 4); }
                    else { const u32x4 v = *(const GAS u32x4*)((const GAS bf16_t*)xin + off);
                        x0 = (f32x4){bflo(v.x), bfhi(v.x), bflo(v.y), bfhi(v.y)}; x1 = (f32x4){bflo(v.z), bfhi(v.z), bflo(v.w), bfhi(v.w)}; }
                    const f32x4 y0 = x0 + g0 * acc[ai][bj][m][0], y1 = x1 + g1 * acc[ai][bj][m][1];
                    if (out_f32) { *(GAS f32x4*)((GAS float*)out + off) = y0; *(GAS f32x4*)((GAS float*)out + off + 4) = y1; }
                    else { u32x4 w; w.x = cvt_pk_bf16(y0[0], y0[1]); w.y = cvt_pk_bf16(y0[2], y0[3]); w.z = cvt_pk_bf16(y1[0], y1[1]); w.w = cvt_pk_bf16(y1[2], y1[3]);
                        *(GAS u32x4*)((GAS bf16_t*)out + off) = w; }
                }
        }
    }
};

template <class Epi>
__device__ __forceinline__ void gemm_phase(int wid_s, LAS unsigned char* lds, const Gemm g, const StaticOrder& S, const Epi& E) {
    const int tid = opaque_tid(wid_s), wid = __builtin_amdgcn_readfirstlane(tid >> 6), lane = tid & 63, wr = wid >> 2, wc = wid & 3, fr = lane & 15, fq = lane >> 4;
    const int K = g.K, nt = K / BK;
    unsigned voffA[2], voffB[2];
#pragma unroll
    for (int i = 0; i < 2; ++i) { int R, C; stage_rc(tid * 16 + i * 8192, R, C); const int Rb = Epi::PERM ? ((R & ~31) + perm32(R & 31)) : R;
        voffA[i] = (unsigned)(R * g.lda + C) * 2u; voffB[i] = (unsigned)(Rb * g.ldb + C) * 2u; }
    const size_t kstep = (size_t)(BK * 2);
    const size_t hsA = (size_t)HALF * g.lda * 2, hsB = (size_t)HALF * g.ldb * 2;
    const size_t tsA = 2 * hsA, tsB = 2 * hsB;
    const unsigned ldsw = (unsigned)wid * 1024u;
    const int aoff = lds_byte(wr * 64 + fr, fq * 8), boff = lds_byte(wc * 32 + fr, fq * 8);
#define PG8_SA(b, h) (((b) * 2 + (h)) * HTB)
#define PG8_SB(b, h) ((4 + (b) * 2 + (h)) * HTB)
#define PG8_STAGE(bufoff, gbase, voff) do { _Pragma("unroll") for (int _i = 0; _i < 2; ++_i) \
        __builtin_amdgcn_global_load_lds((const GAS unsigned*)((const GAS char*)(gbase) + (voff)[_i]), (LAS unsigned*)(lds + (bufoff) + ldsw + _i * 8192), 16, 0, 0); } while (0)
#define PG8_LDA(dst, b, h) do { _Pragma("unroll") for (int m = 0; m < 4; ++m) _Pragma("unroll") for (int k = 0; k < 2; ++k) dst[m][k] = *(const LAS bf16x8*)(lds + PG8_SA(b, h) + aoff + m * 2048 + k * 1024); } while (0)
#define PG8_LDB(dst, b, h) do { _Pragma("unroll") for (int n = 0; n < 2; ++n) _Pragma("unroll") for (int k = 0; k < 2; ++k) dst[n][k] = *(const LAS bf16x8*)(lds + PG8_SB(b, h) + boff + n * 2048 + k * 1024); } while (0)
#define PG8_MMA(ai, bj, At, Bt) do { __builtin_amdgcn_s_setprio(1); _Pragma("unroll") for (int m = 0; m < 4; ++m) _Pragma("unroll") for (int n = 0; n < 2; ++n) _Pragma("unroll") for (int k = 0; k < 2; ++k) \
        acc[ai][bj][m][n] = __builtin_amdgcn_mfma_f32_16x16x32_bf16(Bt[n][k], At[m][k], acc[ai][bj][m][n], 0, 0, 0); __builtin_amdgcn_s_setprio(0); } while (0)
#define PG8_WAIT_V(n) asm volatile("s_waitcnt vmcnt(" #n ")" ::: "memory")
#define PG8_WAIT_L(n) asm volatile("s_waitcnt lgkmcnt(" #n ")" ::: "memory")
#define PG8_BAR __builtin_amdgcn_s_barrier()
#define PG8_SCHED __builtin_amdgcn_sched_barrier(0)
#define PG8_ABASE(u) ((const GAS char*)g.A + (size_t)(u).pm * tsA + (size_t)((u).pn / g.agrp) * g.agoff)
    Unit cur, nxt; int ui = 0;
    if (!S.next(0, cur)) return;
    f32x4 acc[2][2][4][2];
#pragma unroll
    for (int a = 0; a < 2; ++a)
#pragma unroll
        for (int b = 0; b < 2; ++b)
#pragma unroll
            for (int m = 0; m < 4; ++m)
#pragma unroll
                for (int n = 0; n < 2; ++n) acc[a][b][m][n] = (f32x4){0.f, 0.f, 0.f, 0.f};
    bf16x8 At[4][2], B0[2][2], B1[2][2];
    const GAS char* cA = PG8_ABASE(cur); const GAS char* cB = (const GAS char*)g.Bt + (size_t)cur.pn * tsB;
    PG8_STAGE(PG8_SB(0, 0), cB, voffB); PG8_STAGE(PG8_SB(0, 1), cB + hsB, voffB); PG8_STAGE(PG8_SA(0, 0), cA, voffA); PG8_STAGE(PG8_SA(0, 1), cA + hsA, voffA);
    if (wr == 1) PG8_BAR;
    PG8_WAIT_V(2); PG8_BAR;
    PG8_STAGE(PG8_SB(1, 0), cB + kstep, voffB); PG8_STAGE(PG8_SA(1, 0), cA + kstep, voffA); PG8_STAGE(PG8_SB(1, 1), cB + hsB + kstep, voffB);
    PG8_WAIT_V(6); PG8_BAR;
    for (;;) {
        const bool has_next = S.next(ui + 1, nxt);
        const GAS char* nA = has_next ? PG8_ABASE(nxt) : cA; const GAS char* nB = has_next ? (const GAS char*)g.Bt + (size_t)nxt.pn * tsB : cB;
        for (int t = 0; t < nt; t += 2) {
            const bool last = (t == nt - 2);
            const GAS char* a1 = cA + (size_t)(t + 1) * kstep;
            const GAS char* a2 = last ? nA : cA + (size_t)(t + 2) * kstep; const GAS char* b2 = last ? nB : cB + (size_t)(t + 2) * kstep;
            const GAS char* a3 = a2 + kstep; const GAS char* b3 = b2 + kstep;
            PG8_LDB(B0, 0, 0); PG8_LDB(B1, 0, 1); PG8_SCHED; PG8_LDA(At, 0, 0); PG8_STAGE(PG8_SA(1, 1), a1 + hsA, voffA);
            PG8_WAIT_V(8); PG8_WAIT_L(0); PG8_BAR; PG8_MMA(0, 0, At, B0); PG8_MMA(0, 1, At, B1); PG8_BAR; PG8_SCHED;
            PG8_LDA(At, 0, 1); PG8_STAGE(PG8_SB(0, 0), b2, voffB); PG8_STAGE(PG8_SB(0, 1), b2 + hsB, voffB); PG8_STAGE(PG8_SA(0, 0), a2, voffA);
            PG8_WAIT_V(8); PG8_WAIT_L(0); PG8_BAR; PG8_MMA(1, 0, At, B0); PG8_MMA(1, 1, At, B1); PG8_BAR; PG8_SCHED;
            PG8_LDB(B0, 1, 0); PG8_LDB(B1, 1, 1); PG8_SCHED; PG8_LDA(At, 1, 0); PG8_STAGE(PG8_SA(0, 1), a2 + hsA, voffA);
            PG8_WAIT_V(8); PG8_WAIT_L(0); PG8_BAR; PG8_MMA(0, 0, At, B0); PG8_MMA(0, 1, At, B1); PG8_BAR; PG8_SCHED;
            PG8_LDA(At, 1, 1); PG8_STAGE(PG8_SB(1, 0), b3, voffB); PG8_STAGE(PG8_SB(1, 1), b3 + hsB, voffB); PG8_STAGE(PG8_SA(1, 0), a3, voffA);
            PG8_WAIT_V(8); PG8_WAIT_L(0); PG8_BAR; PG8_MMA(1, 0, At, B0); PG8_MMA(1, 1, At, B1); PG8_BAR; PG8_SCHED;
        }
        if (wr == 0) PG8_BAR;
        { const int le = opaque_tid(wid_s) & 63; E(acc, cur, wr, wc, le & 15, le >> 4); }
        if (!has_next) break;
#pragma unroll
        for (int a = 0; a < 2; ++a)
#pragma unroll
            for (int b = 0; b < 2; ++b)
#pragma unroll
                for (int m = 0; m < 4; ++m)
#pragma unroll
                    for (int n = 0; n < 2; ++n) acc[a][b][m][n] = (f32x4){0.f, 0.f, 0.f, 0.f};
        cur = nxt; cA = nA; cB = nB; ++ui;
        if (wr == 1) PG8_BAR;
    }
    PG8_WAIT_V(0);
    PG8_BAR;
#undef PG8_SA
#undef PG8_SB
#undef PG8_STAGE
#undef PG8_LDA
#undef PG8_LDB
#undef PG8_MMA
#undef PG8_WAIT_V
#undef PG8_WAIT_L
#undef PG8_BAR
#undef PG8_SCHED
#undef PG8_ABASE
}
}

struct Params { const float* in[28]; float* out; unsigned char* ws; };
enum { I_X = 0, I_C, I_POS, I_ADAW, I_ADAB, I_F1N, I_F1WI, I_F1WO, I_MIXN, I_MIXW, I_GATEB, I_CONVW, I_CONVB, I_WQ, I_WK, I_ONORM, I_SKIP, I_QN, I_KN, I_SINK,
       I_PA, I_PB, I_MERGEW, I_MERGEB, I_WOUT, I_F2N, I_F2WI, I_F2WO };

__device__ __forceinline__ void cvt_item(const GAS float* W, int Nsrc, int K, GAS bf16_t* WT, int nblk, int item, int mode, float scale, LAS float* scr, int lane) {
    const int kb = item / nblk, nb = item % nblk, k0 = 64 * kb, n0 = 32 * nb;
    const int n = n0 + (lane & 31);
    const float scl = (mode == 2) ? ((n & 128) ? -0.6931471805599453f : -1.4426950408889634f) : scale;
    const int sc = mode == 0 ? n : (mode == 1 ? (n < 3072 ? n : n + 8) : (((n & 128) ? FF : 0) + (n >> 8) * 128 + (n & 127)));
    float tmpw[32];
#pragma unroll
    for (int i = 0; i < 32; ++i) tmpw[i] = W[(size_t)(k0 + 2 * i + (lane >> 5)) * Nsrc + sc];
#pragma unroll
    for (int i = 0; i < 32; ++i) scr[(2 * i + (lane >> 5)) * 33 + (lane & 31)] = tmpw[i] * scl;
    asm volatile("s_waitcnt lgkmcnt(0)" ::: "memory");
    const int c = lane & 7;
#pragma unroll
    for (int j = 0; j < 4; ++j) { const int nn = (lane >> 3) + 8 * j; const LAS float* s = scr + (8 * c) * 33 + nn;
        u32x4 o; o.x = cvt_pk_bf16(s[0 * 33], s[1 * 33]); o.y = cvt_pk_bf16(s[2 * 33], s[3 * 33]); o.z = cvt_pk_bf16(s[4 * 33], s[5 * 33]); o.w = cvt_pk_bf16(s[6 * 33], s[7 * 33]);
        *(GAS u32x4*)(WT + (size_t)(n0 + nn) * K + k0 + 8 * c) = o; }
    asm volatile("s_waitcnt lgkmcnt(0)" ::: "memory");
}
struct CvtJob { const GAS float* W; int Nsrc, K, Ndst; GAS bf16_t* WT; int mode; float scale; };
__device__ __forceinline__ void cvt_run(const CvtJob& j, int& base, int gw, int NGW, LAS float* scr, int lane) {
    const int nblk = j.Ndst / 32, items = (j.K / 64) * nblk;
    int it = gw - (base % NGW); if (it < 0) it += NGW;
    for (; it < items; it += NGW) cvt_item(j.W, j.Nsrc, j.K, j.WT, nblk, it, j.mode, j.scale, scr, lane);
    base += items;
}

__device__ __forceinline__ void mod_phase(int wid_s, LAS unsigned char* lds, const GAS float* c, const GAS float* adaw, const GAS float* adab, GAS float* MOD) {
    const int tid = opaque_tid(wid_s), w = tid >> 6, lane = tid & 63;
    LAS float* sc = (LAS float*)lds;
    LAS float* red = (LAS float*)(lds + 65536);
    for (int i = tid; i < NB * DM; i += 512) sc[i] = fsilu(c[i]);
    __syncthreads();
    for (int item = opaque_bx(); item < 256; item += gridDim.x) {
        const int l = item >> 7, j0 = (item & 127) * 72;
        const GAS float* wp = adaw + (size_t)l * DM * 9216 + j0 + lane;
        const bool has2 = lane < 8;
        float acc[16], acc2[16];
#pragma unroll
        for (int b = 0; b < 16; ++b) { acc[b] = 0.f; acc2[b] = 0.f; }
#pragma unroll 2
        for (int k = w * 128; k < w * 128 + 128; k += 4) {
            const float w0 = wp[(size_t)k * 9216], w1 = wp[(size_t)(k + 1) * 9216], w2 = wp[(size_t)(k + 2) * 9216], w3 = wp[(size_t)(k + 3) * 9216];
            float x0 = 0.f, x1 = 0.f, x2 = 0.f, x3 = 0.f;
            if (has2) { x0 = wp[(size_t)k * 9216 + 64]; x1 = wp[(size_t)(k + 1) * 9216 + 64]; x2 = wp[(size_t)(k + 2) * 9216 + 64]; x3 = wp[(size_t)(k + 3) * 9216 + 64]; }
#pragma unroll
            for (int b = 0; b < 16; ++b) { const f32x4 sv = *(const LAS f32x4*)(sc + b * DM + k);
                acc[b] += sv[0] * w0 + sv[1] * w1 + sv[2] * w2 + sv[3] * w3; acc2[b] += sv[0] * x0 + sv[1] * x1 + sv[2] * x2 + sv[3] * x3; }
        }
#pragma unroll
        for (int b = 0; b < 16; ++b) { red[(w * 16 + b) * 72 + lane] = acc[b]; if (has2) red[(w * 16 + b) * 72 + 64 + lane] = acc2[b]; }
        __syncthreads();
        for (int o = tid; o < 16 * 72; o += 512) { const int b = o / 72, j = o % 72; float sm = adab[l * 9216 + j0 + j];
#pragma unroll
            for (int ww = 0; ww < 8; ++ww) sm += red[(ww * 16 + b) * 72 + j];
            MOD[((size_t)l * NB + b) * 9216 + j0 + j] = sm; }
        __syncthreads();
    }
}

template <bool GATES>
__device__ __forceinline__ void modulate_phase(int wid_s, LAS unsigned char* lds, const GAS void* xin, int in_f32, GAS bf16_t* xcopy, const GAS float* nw, const GAS float* modl, int shc, GAS bf16_t* H,
                                               const GAS float* mixw, const GAS float* gateb, GAS float* IF, GAS float* SSQ) {
    const int tid = opaque_tid(wid_s), w = tid >> 6, lane = tid & 63;
    LAS float* Wg = (LAS float*)lds;
    if (GATES) { for (int i = tid; i < 8192; i += 512) { const int cc = i >> 3, gi = i & 7; Wg[gi * 1024 + cc] = mixw[(size_t)cc * NIN + 3072 + gi]; } __syncthreads(); }
    for (int blk = row_cu(opaque_bx(), gridDim.x); blk < T / 128; blk += gridDim.x) {
        const int b = blk >> 4;
        const GAS float* shp = modl + (size_t)b * 9216 + shc * 1024; const GAS float* scp = shp + 1024;
        f32x4 Af[4], Sf[4];
#pragma unroll
        for (int j = 0; j < 4; ++j) { const int cc = 4 * lane + 256 * j; const f32x4 n4 = *(const GAS f32x4*)(nw + cc), s4 = *(const GAS f32x4*)(scp + cc); Af[j] = n4 * (s4 + 1.0f); Sf[j] = *(const GAS f32x4*)(shp + cc); }
        if (GATES) SSQ[blk * 512 + tid] = 0.f;
        for (int rr = 0; rr < 16; ++rr) {
            const int row = blk * 128 + w * 16 + rr;
            f32x4 v[4]; float ss = 0.f;
            if (in_f32) { const GAS f32x4* xr = (const GAS f32x4*)((const GAS float*)xin + (size_t)row * DM) + lane;
#pragma unroll
                for (int j = 0; j < 4; ++j) v[j] = xr[64 * j]; }
            else { const GAS u32x2* xr = (const GAS u32x2*)((const GAS bf16_t*)xin + (size_t)row * DM) + lane;
#pragma unroll
                for (int j = 0; j < 4; ++j) { const u32x2 uv = xr[64 * j]; v[j] = (f32x4){bflo(uv.x), bfhi(uv.x), bflo(uv.y), bfhi(uv.y)};
                    if (xcopy) *((GAS u32x2*)(xcopy + (size_t)row * DM) + lane + 64 * j) = uv; } }
#pragma unroll
            for (int j = 0; j < 4; ++j) ss += (v[j][0] * v[j][0] + v[j][1] * v[j][1]) + (v[j][2] * v[j][2] + v[j][3] * v[j][3]);
            const float rstd = 1.0f / sqrtf(wave_sum(ss, lane) * (1.0f / DM) + EPS);
#pragma unroll
            for (int j = 0; j < 4; ++j) { v[j] = v[j] * rstd * Af[j] + Sf[j];
                u32x2 o; o.x = cvt_pk_bf16(v[j][0], v[j][1]); o.y = cvt_pk_bf16(v[j][2], v[j][3]);
                *((GAS u32x2*)(H + (size_t)row * DM) + lane + 64 * j) = o; }
            if (GATES) {
                float ga[8];
#pragma unroll
                for (int gi = 0; gi < 8; ++gi) { float a = 0.f;
#pragma unroll
                    for (int j = 0; j < 4; ++j) { const f32x4 wv = *(const LAS f32x4*)(Wg + gi * 1024 + 4 * lane + 256 * j); a += (v[j][0] * wv[0] + v[j][1] * wv[1]) + (v[j][2] * wv[2] + v[j][3] * wv[3]); }
                    ga[gi] = wave_sum(a, lane); }
                float mine = 0.f;
#pragma unroll
                for (int gi = 0; gi < 8; ++gi) mine = (lane == gi) ? ga[gi] : mine;
                if (lane < 8) { float pre = mine + gateb[lane];
                    if (lane >= 4) pre = fminf(pre, 0.f) - 0.6931471805599453f * __builtin_amdgcn_logf(1.0f + fexp(-fabsf(pre)));
                    IF[(size_t)row * 8 + lane] = pre; }
            }
        }
    }
}

__device__ __forceinline__ void conv_phase(int wid_s, const GAS bf16_t* PROJ, const GAS float* cw, const GAS float* cb, GAS bf16_t* UA) {
    const int tid = opaque_tid(wid_s), cg8 = (tid & 127) * 8, rg = tid >> 7;
    float wt[4][8], bb[8];
#pragma unroll
    for (int j = 0; j < 4; ++j)
#pragma unroll
        for (int e = 0; e < 8; ++e) wt[j][e] = cw[j * 1024 + cg8 + e];
#pragma unroll
    for (int e = 0; e < 8; ++e) bb[e] = cb[cg8 + e];
    const int G_ = gridDim.x, rc_ = row_cu(opaque_bx(), G_), per_ = (G_ == 256) ? 2 : 1;
    for (int it_ = rc_ * per_; it_ < T / 64; it_ += (it_ % per_ == per_ - 1) ? (G_ * per_ - (per_ - 1)) : 1) {
        const int item = it_;
        const int r0 = item * 64 + rg * 16;
        float p[3][8];
#pragma unroll
        for (int j = 0; j < 3; ++j) { const int tr = r0 - 3 + j; u32x4 v = (u32x4){0u, 0u, 0u, 0u};
            if ((r0 & (SEQ - 1)) - 3 + j >= 0) v = *(const GAS u32x4*)(PROJ + (size_t)tr * PW + C_U + cg8);
            p[j][0] = bflo(v.x); p[j][1] = bfhi(v.x); p[j][2] = bflo(v.y); p[j][3] = bfhi(v.y); p[j][4] = bflo(v.z); p[j][5] = bfhi(v.z); p[j][6] = bflo(v.w); p[j][7] = bfhi(v.w); }
#pragma unroll 8
        for (int rr = 0; rr < 16; ++rr) {
            const u32x4 v = *(const GAS u32x4*)(PROJ + (size_t)(r0 + rr) * PW + C_U + cg8);
            float cu[8] = {bflo(v.x), bfhi(v.x), bflo(v.y), bfhi(v.y), bflo(v.z), bfhi(v.z), bflo(v.w), bfhi(v.w)};
            float o[8];
#pragma unroll
            for (int e = 0; e < 8; ++e) { o[e] = fsilu(wt[0][e] * p[0][e] + wt[1][e] * p[1][e] + wt[2][e] * p[2][e] + wt[3][e] * cu[e] + bb[e]); p[0][e] = p[1][e]; p[1][e] = p[2][e]; p[2][e] = cu[e]; }
            u32x4 w; w.x = cvt_pk_bf16(o[0], o[1]); w.y = cvt_pk_bf16(o[2], o[3]); w.z = cvt_pk_bf16(o[4], o[5]); w.w = cvt_pk_bf16(o[6], o[7]);
            *(GAS u32x4*)(UA + (size_t)(r0 + rr) * DM + cg8) = w;
        }
    }
}

__device__ __forceinline__ void swa_phase(int wid_s, LAS unsigned char* lds, GAS bf16_t* PROJ, const GAS int* pos, const GAS float* qn, const GAS float* kn, const GAS float* sinks) {
    const int tid = opaque_tid(wid_s), w = tid >> 6, lane = tid & 63, fr = lane & 15, kq = lane >> 4;
    LAS bf16_t* Qs = (LAS bf16_t*)lds;
    LAS bf16_t* Ks = Qs + 256 * 72;
    LAS bf16_t* Vt = Ks + 192 * 72;
    LAS int* posl = (LAS int*)(Vt + 64 * 200);
    LAS float* nrm = (LAS float*)(posl + 256);
    if (tid < 64) nrm[tid] = qn[tid]; else if (tid < 128) nrm[tid] = kn[tid - 64];
    const int G_ = gridDim.x, rc_ = row_cu(opaque_bx(), G_), per_ = (G_ == 256) ? 8 : 1;
    u32x4 pk[3], pv[3]; int ppos = 0;
#define SWA_FETCH(u_) do { const int t_ = opaque_tid(wid_s); const int b_ = (u_) >> 7, n_ = ((u_) >> 2) & 31, hk_ = (u_) & 3, kc_ = n_ >= 2 ? n_ - 2 : 0, nk_ = (n_ - kc_ + 1) * 64; \
        const int tq_ = b_ * SEQ + n_ * 64, tk_ = b_ * SEQ + kc_ * 64; \
        _Pragma("unroll") for (int i = 0; i < 3; ++i) { const int p = t_ + 512 * i; \
            if (p < nk_ * 8) { const int r = p >> 3, pc = p & 7; \
                pk[i] = *(const GAS u32x4*)(PROJ + (size_t)(tk_ + r) * PW + C_K + hk_ * 64 + pc * 8); \
                pv[i] = *(const GAS u32x4*)(PROJ + (size_t)(tk_ + r) * PW + C_VA + hk_ * 64 + pc * 8); } } \
        if (t_ < 64) ppos = pos[tq_ + t_]; else if (t_ < 64 + nk_) ppos = pos[tk_ + t_ - 64]; } while (0)
    const int unit0_ = rc_ * per_;
    if (unit0_ < NB * 32 * 4) SWA_FETCH(unit0_);
    for (int unit = unit0_; unit < NB * 32 * 4; ) {
        const int unit_next = unit + ((unit % per_ == per_ - 1) ? (G_ * per_ - (per_ - 1)) : 1);
        const int tid = opaque_tid(wid_s), w = tid >> 6, lane = tid & 63, fr = lane & 15, kq = lane >> 4;
        const int b = unit >> 7, n = (unit >> 2) & 31, hk = unit & 3;
        const int kc0 = n >= 2 ? n - 2 : 0, nkeys = (n - kc0 + 1) * 64, nkt = nkeys >> 4;
        const int tq0 = b * SEQ + n * 64;
        __syncthreads();
#pragma unroll
        for (int i = 0; i < 4; ++i) { const int p = tid + 512 * i, r = p >> 3, pc = p & 7, g = r >> 6, qi = r & 63;
            *(LAS u32x4*)(Qs + r * 72 + pc * 8) = *(const GAS u32x4*)(PROJ + (size_t)(tq0 + qi) * PW + C_Q + (hk * 4 + g) * 64 + pc * 8); }
#pragma unroll
        for (int i = 0; i < 3; ++i) { const int p = tid + 512 * i;
            if (p < nkeys * 8) { const int r = p >> 3, pc = p & 7;
                *(LAS u32x4*)(Ks + r * 72 + pc * 8) = pk[i];
                const u32x4 vv = pv[i];
                LAS bf16_t* vp = Vt + (pc * 8) * 200 + r;
                vp[0] = (bf16_t)(vv.x & 0xffffu); vp[200] = (bf16_t)(vv.x >> 16); vp[400] = (bf16_t)(vv.y & 0xffffu); vp[600] = (bf16_t)(vv.y >> 16);
                vp[800] = (bf16_t)(vv.z & 0xffffu); vp[1000] = (bf16_t)(vv.z >> 16); vp[1200] = (bf16_t)(vv.w & 0xffffu); vp[1400] = (bf16_t)(vv.w >> 16); } }
        if (tid < 64 + nkeys) posl[tid] = ppos;
        if (unit_next < NB * 32 * 4) SWA_FETCH(unit_next);
        __syncthreads();
        if (tid < 256 + nkeys) {
            const bool isq = tid < 256;
            LAS bf16_t* rp = isq ? Qs + tid * 72 : Ks + (tid - 256) * 72;
            const LAS float* nw = nrm + (isq ? 0 : 64);
            unsigned xw[32];
#pragma unroll
            for (int i = 0; i < 8; ++i) { const u32x4 v = *(const LAS u32x4*)(rp + 8 * i); xw[4 * i] = v.x; xw[4 * i + 1] = v.y; xw[4 * i + 2] = v.z; xw[4 * i + 3] = v.w; }
            float ss = 0.f;
#pragma unroll
            for (int j = 0; j < 32; ++j) { const float a = bflo(xw[j]), b = bfhi(xw[j]); ss += a * a + b * b; }
            const float rstd = 1.0f / sqrtf(ss * (1.0f / 64.0f) + EPS);
            const float pf = (float)posl[isq ? (tid & 63) : (64 + tid - 256)];
#pragma unroll
            for (int j = 0; j < 16; ++j) {
                float o1[2], o2[2];
#pragma unroll
                for (int e = 0; e < 2; ++e) { const int i = 2 * j + e;
                    const float y1 = (e ? bfhi(xw[j]) : bflo(xw[j])) * rstd * nw[i], y2 = (e ? bfhi(xw[16 + j]) : bflo(xw[16 + j])) * rstd * nw[i + 32];
                    const float ang = pf * INV_FREQ[i];
                    double rev = (double)ang * 0.15915494309189535; rev -= __builtin_rint(rev);
                    const float fr_ = (float)rev, sn = __builtin_amdgcn_sinf(fr_), cs = __builtin_amdgcn_cosf(fr_);
                    o1[e] = y1 * cs - y2 * sn; o2[e] = y2 * cs + y1 * sn; }
                xw[j] = cvt_pk_bf16(o1[0], o1[1]); xw[16 + j] = cvt_pk_bf16(o2[0], o2[1]);
            }
#pragma unroll
            for (int i = 0; i < 8; ++i) { u32x4 v; v.x = xw[4 * i]; v.y = xw[4 * i + 1]; v.z = xw[4 * i + 2]; v.w = xw[4 * i + 3]; *(LAS u32x4*)(rp + 8 * i) = v; }
        }
        __syncthreads();
        const float sink = sinks[hk * 4 + (w >> 1)];
#pragma unroll
        for (int qt = 0; qt < 2; ++qt) {
            const int qrow = 32 * w + 16 * qt + fr;
            bf16x8 qf[2];
#pragma unroll
            for (int ks = 0; ks < 2; ++ks) qf[ks] = *(const LAS bf16x8*)(Qs + qrow * 72 + 32 * ks + 8 * kq);
            f32x4 s[12];
#pragma unroll
            for (int t = 0; t < 12; ++t) { s[t] = (f32x4){0.f, 0.f, 0.f, 0.f};
                if (t < nkt) {
#pragma unroll
                    for (int ks = 0; ks < 2; ++ks) { const bf16x8 a = *(const LAS bf16x8*)(Ks + (16 * t + fr) * 72 + 32 * ks + 8 * kq); s[t] = MFMA16(a, qf[ks], s[t]); } } }
            float mx = sink;
#pragma unroll
            for (int t = 0; t < 12; ++t) if (t < nkt) {
#pragma unroll
                for (int e = 0; e < 4; ++e) { s[t][e] *= 0.125f; mx = fmaxf(mx, s[t][e]); } }
            mx = fmaxf(mx, shx(mx, lane, 16)); mx = fmaxf(mx, shx(mx, lane, 32));
            float sum = 0.f;
#pragma unroll
            for (int t = 0; t < 12; ++t) if (t < nkt) {
#pragma unroll
                for (int e = 0; e < 4; ++e) { const float p = fexp(s[t][e] - mx); s[t][e] = p; sum += p; } }
            sum += shx(sum, lane, 16); sum += shx(sum, lane, 32);
            const float inv = 1.0f / (sum + fexp(sink - mx));
            f32x4 o[4];
#pragma unroll
            for (int dt = 0; dt < 4; ++dt) o[dt] = (f32x4){0.f, 0.f, 0.f, 0.f};
#pragma unroll
            for (int k2 = 0; k2 < 6; ++k2) if (2 * k2 < nkt) {
                u32x4 pk; pk.x = cvt_pk_bf16(s[2 * k2][0], s[2 * k2][1]); pk.y = cvt_pk_bf16(s[2 * k2][2], s[2 * k2][3]);
                pk.z = cvt_pk_bf16(s[2 * k2 + 1][0], s[2 * k2 + 1][1]); pk.w = cvt_pk_bf16(s[2 * k2 + 1][2], s[2 * k2 + 1][3]);
                const bf16x8 pf = __builtin_bit_cast(bf16x8, pk);
#pragma unroll
                for (int dt = 0; dt < 4; ++dt) {
                    const LAS bf16_t* vp = Vt + (16 * dt + fr) * 200 + 32 * k2 + 4 * kq;
                    const bf16x4 lo = *(const LAS bf16x4*)vp, hi = *(const LAS bf16x4*)(vp + 16);
                    const bf16x8 a = __builtin_shufflevector(lo, hi, 0, 1, 2, 3, 4, 5, 6, 7);
                    o[dt] = MFMA16(a, pf, o[dt]); } }
            const int g = qrow >> 6, qi = qrow & 63;
            GAS bf16_t* op = PROJ + (size_t)(tq0 + qi) * PW + C_Q + (hk * 4 + g) * 64 + 4 * kq;
#pragma unroll
            for (int dt = 0; dt < 4; ++dt) { u32x2 wv; wv.x = cvt_pk_bf16(o[dt][0] * inv, o[dt][1] * inv); wv.y = cvt_pk_bf16(o[dt][2] * inv, o[dt][3] * inv);
                *(GAS u32x2*)(op + 16 * dt) = wv; }
        }
        unit = unit_next;
    }
#undef SWA_FETCH
}

__device__ __forceinline__ void mlstm_phase(int wid_s, LAS unsigned char* lds, GAS bf16_t* PROJ, const GAS bf16_t* KM, const GAS float* IF, GAS float* SSQ) {
    const int tid = opaque_tid(wid_s), w = __builtin_amdgcn_readfirstlane(tid >> 6), lane = tid & 63, fr = lane & 15, kq = lane >> 4;
    LAS bf16_t* Qs = (LAS bf16_t*)lds;
    LAS bf16_t* Ks = Qs + 64 * 264;
    LAS bf16_t* Ct = Ks + 64 * 264;
    LAS bf16_t* Vt = Ct + 80 * 264;
    LAS bf16_t* Vw = Vt + 80 * 72;
    LAS bf16_t* Sw = Vw + 80 * 72;
    LAS float* vec = (LAS float*)(Sw + 64 * 72);
    const int tt = w & 3, wh = w >> 2, ndv = wh ? 2 : 3, dv0 = wh ? 3 : 0, nh = wh ? 1 : 3;
    for (int unit = row_cu(opaque_bx(), gridDim.x); unit < 256; unit += gridDim.x) {
        const int bh = unit >> 2, dvq = unit & 3, b = bh >> 2, h = bh & 3;
        __syncthreads();
        for (int i = tid; i < 80 * 264 / 2; i += 512) ((LAS unsigned*)Ct)[i] = 0u;
        for (int i = tid; i < 16 * 72; i += 512) { Vt[64 * 72 + i] = (i < 64) ? (bf16_t)0x3f80 : (bf16_t)0; Vw[64 * 72 + i] = 0; }
        f32x4 Cacc[2][5];
#pragma unroll
        for (int i = 0; i < 2; ++i)
#pragma unroll
            for (int j = 0; j < 5; ++j) Cacc[i][j] = (f32x4){0.f, 0.f, 0.f, 0.f};
        float m = 0.f;
        u32x4 nq[4], nk[4], nv; float nli, nlf;
        const unsigned voq = (unsigned)(((tid >> 5) * PW + (tid & 31) * 8) * 2), vok = (unsigned)(((tid >> 5) * DM + (tid & 31) * 8) * 2);
        const unsigned vov = (unsigned)(((tid >> 3) * PW + (tid & 7) * 8) * 2), voi = (unsigned)lane * 32u;
#define MLSTM_FETCH(t1) do { \
          const GAS char* qb_ = (const GAS char*)(PROJ + (size_t)(t1) * PW + C_U + h * 256); const GAS char* kb_ = (const GAS char*)(KM + (size_t)(t1) * DM + h * 256); \
          const GAS char* vb_ = (const GAS char*)(PROJ + (size_t)(t1) * PW + C_V + h * 256 + dvq * 64); const GAS char* ib_ = (const GAS char*)(IF + (size_t)(t1) * 8 + h); \
          nli = *(const GAS float*)(ib_ + voi); nlf = *(const GAS float*)(ib_ + 16 + voi); \
          _Pragma("unroll") for (int i = 0; i < 4; ++i) { nq[i] = *(const GAS u32x4*)(qb_ + (size_t)i * 16 * PW * 2 + voq); nk[i] = *(const GAS u32x4*)(kb_ + (size_t)i * 16 * DM * 2 + vok); } \
          nv = *(const GAS u32x4*)(vb_ + vov); } while (0)
        MLSTM_FETCH(b * SEQ);
        f32x4 num[3];
#define MLSTM_OUT(t_out, vc_out) do { \
                const f32x4 den4 = *(const LAS f32x4*)((vc_out) + 192 + 16 * tt + 4 * kq), b4 = *(const LAS f32x4*)((vc_out) + 128 + 16 * tt + 4 * kq), Mo4 = *(const LAS f32x4*)((vc_out) + 64 + 16 * tt + 4 * kq); \
                float dd[4], ss[4]; \
                _Pragma("unroll") for (int e = 0; e < 4; ++e) { dd[e] = 1.0f / fmaxf(fabsf(den4[e]), fexp(-(b4[e] + Mo4[e]))); ss[e] = 0.f; } \
                _Pragma("unroll") for (int j = 0; j < 3; ++j) if (j < nh) { \
                    _Pragma("unroll") for (int e = 0; e < 4; ++e) { const float hv = num[j][e] * dd[e]; ss[e] += hv * hv; \
                        PROJ[(size_t)((t_out) + 16 * tt + 4 * kq + e) * PW + C_V + h * 256 + dvq * 64 + 16 * (dv0 + j) + fr] = f2bf(hv); } } \
                _Pragma("unroll") for (int e = 0; e < 4; ++e) { float v = ss[e]; \
                    v += DPP_F(v, v, 0x128, 0xf); v += DPP_F(v, v, 0x124, 0xf); v += DPP_F(v, v, 0x122, 0xf); v += DPP_F(v, v, 0x121, 0xf); \
                    if (fr == 0) __hip_atomic_fetch_add(SSQ + (size_t)((t_out) + 16 * tt + 4 * kq + e) * 4 + h, v, __ATOMIC_RELAXED, __HIP_MEMORY_SCOPE_AGENT); } } while (0)
#pragma unroll 1
        for (int c = 0; c < 32; ++c) {
            const int t0 = b * SEQ + c * 64;
            LAS float* vc = vec + (c & 1) * 256;
            const float li = nli, lf = nlf;
            const float bcs = scan_sum64(lf);
            const float uu = li - bcs;
            const float cm = scan_max64(uu);
            const float Mv = fmaxf(m, cm);
            const float b63 = __int_as_float(__builtin_amdgcn_readlane(__float_as_int(bcs), 63)), cm63 = __int_as_float(__builtin_amdgcn_readlane(__float_as_int(cm), 63)), Mend = fmaxf(m, cm63);
            const float wg = fexp(uu - Mend), decay = fexp(m - Mend), m_old = m;
            m = b63 + Mend;
            if (w == 0) { vc[lane] = uu; vc[64 + lane] = Mv; vc[128 + lane] = bcs; Vw[64 * 72 + lane] = f2bf(wg); }
#pragma unroll
            for (int i = 0; i < 4; ++i) { const int p = tid + 512 * i, r = p >> 5, pc = p & 31;
                *(LAS u32x4*)(Qs + r * 264 + pc * 8) = nq[i];
                *(LAS u32x4*)(Ks + r * 264 + pc * 8) = nk[i]; }
            { const int r = tid >> 3, pc = tid & 7;
              const float wgr = shi(wg, r & 63);
              const unsigned vs[4] = {nv.x, nv.y, nv.z, nv.w};
#pragma unroll
              for (int e = 0; e < 4; ++e) { const int d = pc * 8 + 2 * e;
                  Vt[d * 72 + r] = (bf16_t)(vs[e] & 0xffffu); Vt[(d + 1) * 72 + r] = (bf16_t)(vs[e] >> 16);
                  Vw[d * 72 + r] = f2bf(bflo(vs[e]) * wgr); Vw[(d + 1) * 72 + r] = f2bf(bfhi(vs[e]) * wgr); } }
            if (c + 1 < 32) MLSTM_FETCH(t0 + 64);
            if (c > 0) MLSTM_OUT(t0 - 64, vec + ((c - 1) & 1) * 256);
            __syncthreads();
            bf16x8 qfr[8];
#pragma unroll
            for (int ks = 0; ks < 8; ++ks) qfr[ks] = *(const LAS bf16x8*)(Qs + (16 * tt + fr) * 264 + 32 * ks + 8 * kq);
            {
                const int t = 16 * tt + fr; const float Mt = vc[64 + t];
#pragma unroll
                for (int si = 0; si < 2; ++si) { const int st = 2 * wh + si; f32x4 sa = (f32x4){0.f, 0.f, 0.f, 0.f};
                    if (st <= tt) {
#pragma unroll
                        for (int ks = 0; ks < 8; ++ks) { const bf16x8 a = *(const LAS bf16x8*)(Ks + (16 * st + fr) * 264 + 32 * ks + 8 * kq); sa = MFMA16(a, qfr[ks], sa); } }
                    const f32x4 u4 = *(const LAS f32x4*)(vc + 16 * st + 4 * kq);
#pragma unroll
                    for (int e = 0; e < 4; ++e) { const int s = 16 * st + 4 * kq + e; const float wgt = (s <= t) ? fexp(u4[e] - Mt) : 0.f; sa[e] *= wgt; }
                    u32x2 pk; pk.x = cvt_pk_bf16(sa[0], sa[1]); pk.y = cvt_pk_bf16(sa[2], sa[3]);
                    *(LAS u32x2*)(Sw + t * 72 + 16 * st + 4 * kq) = pk; }
            }
#pragma unroll
            for (int j = 0; j < 3; ++j) num[j] = (f32x4){0.f, 0.f, 0.f, 0.f};
#pragma unroll
            for (int ks = 0; ks < 8; ++ks) { const bf16x8 aq = qfr[ks];
#pragma unroll
                for (int j = 0; j < 3; ++j) if (j < ndv) { const bf16x8 bc = *(const LAS bf16x8*)(Ct + (16 * (dv0 + j) + fr) * 264 + 32 * ks + 8 * kq); num[j] = MFMA16(aq, bc, num[j]); } }
            const f32x4 M4 = *(const LAS f32x4*)(vc + 64 + 16 * tt + 4 * kq);
#pragma unroll
            for (int e = 0; e < 4; ++e) { const float wi = fexp(m_old - M4[e]);
#pragma unroll
                for (int j = 0; j < 3; ++j) num[j][e] *= wi; }
            __syncthreads();
#pragma unroll
            for (int ks = 0; ks < 2; ++ks) { const bf16x8 as = *(const LAS bf16x8*)(Sw + (16 * tt + fr) * 72 + 32 * ks + 8 * kq);
#pragma unroll
                for (int j = 0; j < 3; ++j) if (j < ndv) { const bf16x8 bv = *(const LAS bf16x8*)(Vt + (16 * (dv0 + j) + fr) * 72 + 32 * ks + 8 * kq); num[j] = MFMA16(as, bv, num[j]); } }
#pragma unroll
            for (int i = 0; i < 2; ++i)
#pragma unroll
                for (int j = 0; j < 5; ++j) Cacc[i][j] *= decay;
#pragma unroll
            for (int ks = 0; ks < 2; ++ks) {
                bf16x8 ak[2];
#pragma unroll
                for (int i = 0; i < 2; ++i) { const LAS bf16_t* kp = Ks + (32 * ks + 8 * kq) * 264 + 16 * (2 * w + i) + fr;
#pragma unroll
                    for (int e = 0; e < 8; ++e) ak[i][e] = (short)kp[e * 264]; }
#pragma unroll
                for (int j = 0; j < 5; ++j) { const bf16x8 bv = *(const LAS bf16x8*)(Vw + (16 * j + fr) * 72 + 32 * ks + 8 * kq);
#pragma unroll
                    for (int i = 0; i < 2; ++i) Cacc[i][j] = MFMA16(ak[i], bv, Cacc[i][j]); } }
            if (wh == 1 && fr == 0) *(LAS f32x4*)(vc + 192 + 16 * tt + 4 * kq) = num[1];
#pragma unroll
            for (int i = 0; i < 2; ++i)
#pragma unroll
                for (int j = 0; j < 5; ++j) { u32x2 pk; pk.x = cvt_pk_bf16(Cacc[i][j][0], Cacc[i][j][1]); pk.y = cvt_pk_bf16(Cacc[i][j][2], Cacc[i][j][3]);
                    *(LAS u32x2*)(Ct + (16 * j + fr) * 264 + 16 * (2 * w + i) + 4 * kq) = pk; }
            __syncthreads();
        }
        MLSTM_OUT(b * SEQ + 31 * 64, vec + 256);
    }
#undef MLSTM_OUT
}

__device__ __forceinline__ void fixup_phase(int wid_s, GAS bf16_t* PROJ, const GAS bf16_t* UA, const GAS float* SSQ, const GAS float* onorm, const GAS float* skip) {
    const int tid = opaque_tid(wid_s), cg8 = (tid & 127) * 8, rg = tid >> 7, hd = cg8 >> 8;
    float on[8], sk[8];
#pragma unroll
    for (int e = 0; e < 8; ++e) { on[e] = onorm[cg8 + e]; sk[e] = skip[cg8 + e]; }
    const int G_ = gridDim.x, rc_ = row_cu(opaque_bx(), G_), per_ = (G_ == 256) ? 2 : 1;
    for (int it_ = rc_ * per_; it_ < T / 64; it_ += (it_ % per_ == per_ - 1) ? (G_ * per_ - (per_ - 1)) : 1) {
        const int item = it_;
#pragma unroll 4
        for (int rr = 0; rr < 16; ++rr) {
            const size_t row = (size_t)item * 64 + rg * 16 + rr;
            const u32x4 hv = *(const GAS u32x4*)(PROJ + row * PW + C_V + cg8), ov = *(const GAS u32x4*)(PROJ + row * PW + C_O + cg8), uv = *(const GAS u32x4*)(UA + row * DM + cg8);
            const float rstd = 1.0f / sqrtf(SSQ[row * 4 + hd] * (1.0f / 256.0f) + EPS);
            const float hh[8] = {bflo(hv.x), bfhi(hv.x), bflo(hv.y), bfhi(hv.y), bflo(hv.z), bfhi(hv.z), bflo(hv.w), bfhi(hv.w)};
            const float oo[8] = {bflo(ov.x), bfhi(ov.x), bflo(ov.y), bfhi(ov.y), bflo(ov.z), bfhi(ov.z), bflo(ov.w), bfhi(ov.w)};
            const float ua[8] = {bflo(uv.x), bfhi(uv.x), bflo(uv.y), bfhi(uv.y), bflo(uv.z), bfhi(uv.z), bflo(uv.w), bfhi(uv.w)};
            float y[8];
#pragma unroll
            for (int e = 0; e < 8; ++e) y[e] = fsigmoid(oo[e]) * (hh[e] * rstd * on[e] + sk[e] * ua[e]);
            u32x4 wv; wv.x = cvt_pk_bf16(y[0], y[1]); wv.y = cvt_pk_bf16(y[2], y[3]); wv.z = cvt_pk_bf16(y[4], y[5]); wv.w = cvt_pk_bf16(y[6], y[7]);
            *(GAS u32x4*)(PROJ + row * PW + C_O + cg8) = wv;
        }
    }
}


#define XB_TMO      128
#define XB_XCNT(j)  (256  + 64 * (j))
#define XB_XSUB(j)  (1280 + 64 * (j))
#define XB_XGEN(j)  (2304 + 64 * (j))
#define XB_TOP      3328
#define XB_TOPGEN   3392
#define XCD_BAR_WORDS 3456
#define XB_SPIN_CAP (1u << 19)
__device__ __forceinline__ unsigned xb_ld(GAS unsigned* p)              { return __hip_atomic_load(p, __ATOMIC_RELAXED, __HIP_MEMORY_SCOPE_AGENT); }
__device__ __forceinline__ unsigned xb_add(GAS unsigned* p, unsigned v) { return __hip_atomic_fetch_add(p, v, __ATOMIC_RELAXED, __HIP_MEMORY_SCOPE_AGENT); }
__device__ __forceinline__ unsigned xb_xcc_id() { return (unsigned)__builtin_amdgcn_s_getreg((3 << 11) | 20) & 0xFu; }
#define XB_SPIN(cond, bar) do { unsigned _sp = 0; while (cond) { __builtin_amdgcn_s_sleep(1); \
    if ((++_sp & 255u) == 0u) { if (xb_ld(&(bar)[XB_TMO])) break; if (_sp > XB_SPIN_CAP) { xb_add(&(bar)[XB_TMO], 1u); break; } } } } while (0)
__device__ __forceinline__ void xcd_barrier_complete(GAS unsigned* bar, unsigned x, unsigned& nloc, unsigned& nx) {
    const unsigned G = gridDim.x;
    unsigned sum, cnt, mine, sp = 0u;
    for (;;) {
        sum = 0u; cnt = 0u; mine = 0u;
#pragma unroll
        for (unsigned j = 0; j < 16; ++j) { const unsigned c = xb_ld(&bar[XB_XCNT(j)]); sum += c; cnt += (c > 0u) ? 1u : 0u; mine = (j == x) ? c : mine; }
        if (sum == G) break;
        __builtin_amdgcn_s_sleep(1);
        if ((++sp & 255u) == 0u) { if (xb_ld(&bar[XB_TMO])) break; if (sp > XB_SPIN_CAP) { xb_add(&bar[XB_TMO], 1u); break; } }
    }
    nloc = mine > 0u ? mine : 1u; nx = cnt > 0u ? cnt : 1u;
}
__device__ __forceinline__ void grid_barrier(int wid_s, GAS unsigned* bar, volatile LAS unsigned* st) {
    const int tid = opaque_tid(wid_s);
    asm volatile("s_waitcnt vmcnt(0)" ::: "memory");
    __syncthreads();
    if (tid == 0) {
        __builtin_amdgcn_s_waitcnt(0);
        const unsigned x = xb_xcc_id();
        unsigned nloc = st[0], nx = st[1];
        if (nloc == 0u) { xcd_barrier_complete(bar, x, nloc, nx); st[0] = nloc; st[1] = nx; }
        const unsigned old = xb_add(&bar[XB_XSUB(x)], 1u);
        const unsigned gen = old / nloc;
        if (old + 1u == (gen + 1u) * nloc) {
            __builtin_amdgcn_fence(__ATOMIC_RELEASE, "agent");
            asm volatile("s_waitcnt vmcnt(0)" ::: "memory");
            const unsigned og = xb_add(&bar[XB_TOP], 1u);
            const unsigned tg = og / nx;
            if (og + 1u == (tg + 1u) * nx) xb_add(&bar[XB_TOPGEN], 1u);
            else XB_SPIN(xb_ld(&bar[XB_TOPGEN]) == tg, bar);
            __builtin_amdgcn_fence(__ATOMIC_ACQUIRE, "agent");
            xb_add(&bar[XB_XGEN(x)], 1u);
            asm volatile("s_waitcnt vmcnt(0)" ::: "memory");
        } else {
            XB_SPIN(xb_ld(&bar[XB_XGEN(x)]) == gen, bar);
            __builtin_amdgcn_fence(__ATOMIC_ACQUIRE, "agent");
            asm volatile("s_waitcnt vmcnt(0)" ::: "memory");
        }
    }
    __syncthreads();
}

#define XL_CNT(j) (3520 + 64 * (j))
#define XL_WORDS 4608
__device__ __forceinline__ void xcd_local_barrier(int wid_s, GAS unsigned* bar, volatile LAS unsigned* st) {
    const int tid = opaque_tid(wid_s);
    asm volatile("s_waitcnt vmcnt(0)" ::: "memory");
    __syncthreads();
    if (tid == 0) {
        const unsigned x = xb_xcc_id(), nloc = st[0];
        const unsigned old = xb_add(&bar[XL_CNT(x)], 1u), target = (old / nloc + 1u) * nloc;
        XB_SPIN(xb_ld(&bar[XL_CNT(x)]) < target, bar);
        __builtin_amdgcn_fence(__ATOMIC_ACQUIRE, "agent");
        asm volatile("s_waitcnt vmcnt(0)" ::: "memory");
    }
    __syncthreads();
}

typedef const __attribute__((address_space(4))) unsigned long long* kargp_t;
__device__ __forceinline__ unsigned long long ldarg(int i) { kargp_t kp = (kargp_t)__builtin_amdgcn_kernarg_segment_ptr(); asm volatile("" : "+s"(kp)); return kp[i]; }
#define PIN(i) ((const GAS float*)ldarg(i))
#define POUT ((GAS float*)ldarg(28))
#define WSP(off) ((GAS unsigned char*)ldarg(29) + (off))
#define WB(off) ((GAS bf16_t*)(((sidx & 1) ? WSP(WS_W) : ((GAS unsigned char*)ldarg(28) + 64 * MiB)) + (off)))
#define MODL(l) ((const GAS float*)WSP(WS_MOD) + (size_t)(l) * NB * 9216)

__global__ void __launch_bounds__(512, 2) mega_fwd(Params p) {
    extern __shared__ __attribute__((aligned(16))) unsigned char lds_raw[];
    LAS unsigned char* lds = (LAS unsigned char*)lds_raw;
    const int wid_s = __builtin_amdgcn_readfirstlane((int)(threadIdx.x >> 6));
    volatile LAS unsigned* bst = (volatile LAS unsigned*)(lds + LDS_BYTES - 16);
    { GAS unsigned* bar = (GAS unsigned*)WSP(0);
      if (threadIdx.x == 0) { *(volatile LAS int*)VBX_LDS_ADDR = (int)blockIdx.x; bst[0] = 0u; bst[1] = 0u; }
      if (blockIdx.x == 0) for (int i = threadIdx.x; i < XL_WORDS; i += 512) __hip_atomic_store(bar + i, 0u, __ATOMIC_RELAXED, __HIP_MEMORY_SCOPE_AGENT);
      __syncthreads();
      mod_phase(wid_s, lds, PIN(I_C), PIN(I_ADAW), PIN(I_ADAB), (GAS float*)WSP(WS_MOD));
      cg::this_grid().sync();
      const unsigned xcc = xb_xcc_id(); unsigned rank = 0u;
      if (threadIdx.x == 0) rank = xb_add(bar + XB_XCNT(xcc & 15u), 1u);
      grid_barrier(wid_s, bar, bst);
      if (threadIdx.x == 0) {
          bool ok = (gridDim.x == 256) && (xcc < 8u);
          for (int j = 0; j < 16; ++j) ok = ok && (xb_ld(bar + XB_XCNT(j)) == (j < 8 ? 32u : 0u));
          if (ok) *(volatile LAS int*)VBX_LDS_ADDR = (int)(xcc + 8u * rank);
          *(volatile LAS int*)(VBX_LDS_ADDR + 4u) = ok ? 1 : 0;
      }
      __syncthreads(); }
#define GRID_SYNC() grid_barrier(wid_s, (GAS unsigned*)WSP(0), bst)
#define XCD_SYNC() do { if (__builtin_amdgcn_readfirstlane(*(volatile LAS int*)(VBX_LDS_ADDR + 4u))) xcd_local_barrier(wid_s, (GAS unsigned*)WSP(0), bst); else grid_barrier(wid_s, (GAS unsigned*)WSP(0), bst); } while (0)

#pragma unroll 1
    for (int l = 0; l < 2; ++l) {
#pragma unroll 1
        for (int stage = 0; stage < 3; ++stage) {
            const int G = gridDim.x, bx = opaque_bx();
            const int sidx = l * 3 + stage;
            if (stage != 1) {
                const int f = stage >> 1;
                {
                    const int tid = opaque_tid(wid_s), wv = tid >> 6, lane = tid & 63, gw = bx * 8 + wv, NGW = G * 8;
                    LAS float* cscr = (LAS float*)(lds + 32768 + wv * 8448);
                    const bool first = (l == 0 && stage == 0), last = (l == 1 && stage == 2);
                    const GAS void* xin = first ? (const GAS void*)PIN(I_X) : (const GAS void*)POUT;
                    modulate_phase<false>(wid_s, lds, xin, first ? 1 : 0, last ? (GAS bf16_t*)WSP(WS_UA) : (GAS bf16_t*)nullptr, PIN(f ? I_F2N : I_F1N) + l * DM, MODL(l), f ? 6 : 0, (GAS bf16_t*)WSP(WS_H), nullptr, nullptr, nullptr, nullptr);
                    int base = 0;
                    CvtJob j1{PIN(f ? I_F2WI : I_F1WI) + (size_t)l * DM * 2 * FF, 2 * FF, DM, 2 * FF, WB(W_F1), 2, 1.0f}; cvt_run(j1, base, gw, NGW, cscr, lane);
                    CvtJob j2{PIN(f ? I_F2WO : I_F1WO) + (size_t)l * FF * DM, DM, FF, DM, WB(W_F2), 0, 1.0f}; cvt_run(j2, base, gw, NGW, cscr, lane);
                }
                GRID_SYNC();
                { pg8::Gemm g{(GAS bf16_t*)WSP(WS_H), WB(W_F1), T, 2 * FF, DM, DM, DM, 1 << 30, 0}; pg8::StaticOrder S; S.init(T, 2 * FF, G, bx);
                  pg8::EpiSwiGLU E{(GAS bf16_t*)WSP(WS_PROJ), FF}; pg8::gemm_phase(wid_s, lds, g, S, E); }
                XCD_SYNC();
                { pg8::Gemm g{(GAS bf16_t*)WSP(WS_PROJ), WB(W_F2), T, DM, FF, FF, FF, 1 << 30, 0}; pg8::StaticOrder S; S.init(T, DM, G, bx);
                  const bool first = (l == 0 && stage == 0), last = (l == 1 && stage == 2);
                  const GAS void* xin = first ? (const GAS void*)PIN(I_X) : (last ? (const GAS void*)WSP(WS_UA) : (const GAS void*)POUT);
                  pg8::EpiRes E{xin, (GAS void*)POUT, MODL(l) + (f ? 8 : 2) * 1024, 9216, 0.5f, first ? 1 : 0, last ? 1 : 0}; pg8::gemm_phase(wid_s, lds, g, S, E); }
                XCD_SYNC();
            } else {
                {
                    const int tid = opaque_tid(wid_s), wv = tid >> 6, lane = tid & 63, gw = bx * 8 + wv, NGW = G * 8;
                    LAS float* cscr = (LAS float*)(lds + 32768 + wv * 8448);
                    const GAS float* mixw = PIN(I_MIXW) + (size_t)l * DM * NIN;
                    modulate_phase<true>(wid_s, lds, (const GAS void*)POUT, 0, (GAS bf16_t*)nullptr, PIN(I_MIXN) + l * DM, MODL(l), 3, (GAS bf16_t*)WSP(WS_H), mixw, PIN(I_GATEB) + l * 8, (GAS float*)WSP(WS_IF), (GAS float*)WSP(WS_SSQ));
                    int base = 0;
                    CvtJob j1{mixw, NIN, DM, PW, WB(W_MIX), 1, 1.0f}; cvt_run(j1, base, gw, NGW, cscr, lane);
                    CvtJob j2{PIN(I_MERGEW) + (size_t)l * DM * 2 * DM, 2 * DM, DM, 2 * DM, WB(W_MERGE), 0, -1.4426950408889634f}; cvt_run(j2, base, gw, NGW, cscr, lane);
                    CvtJob j3{PIN(I_PA) + (size_t)l * DM * DM, DM, DM, DM, WB(W_PA), 0, 1.0f}; cvt_run(j3, base, gw, NGW, cscr, lane);
                    CvtJob j4{PIN(I_PB) + (size_t)l * DM * DM, DM, DM, DM, WB(W_PB), 0, 1.0f}; cvt_run(j4, base, gw, NGW, cscr, lane);
                    CvtJob j5{PIN(I_WOUT) + (size_t)l * DM * DM, DM, DM, DM, WB(W_WO), 0, 1.0f}; cvt_run(j5, base, gw, NGW, cscr, lane);
#pragma unroll 1
                    for (int hd = 0; hd < 4; ++hd) {
                        CvtJob jq{PIN(I_WQ) + ((size_t)l * 4 + hd) * 65536, 256, 256, 256, WB(W_QK) + (size_t)hd * 512 * 256, 0, 1.0f}; cvt_run(jq, base, gw, NGW, cscr, lane);
                        CvtJob jk{PIN(I_WK) + ((size_t)l * 4 + hd) * 65536, 256, 256, 256, WB(W_QK) + (size_t)hd * 512 * 256 + 256 * 256, 0, 0.0625f}; cvt_run(jk, base, gw, NGW, cscr, lane);
                    }
                }
                GRID_SYNC();
                { pg8::Gemm g{(GAS bf16_t*)WSP(WS_H), WB(W_MIX), T, PW, DM, DM, DM, 1 << 30, 0}; pg8::StaticOrder S; S.init(T, PW, G, bx);
                  GAS bf16_t* PROJ = (GAS bf16_t*)WSP(WS_PROJ);
                  pg8::EpiStore2 E{PROJ, PW, PROJ, PW, 1 << 30, nullptr, 0}; pg8::gemm_phase(wid_s, lds, g, S, E); }
                XCD_SYNC();
                conv_phase(wid_s, (GAS bf16_t*)WSP(WS_PROJ), PIN(I_CONVW) + l * 4 * DM, PIN(I_CONVB) + l * DM, (GAS bf16_t*)WSP(WS_UA));
                swa_phase(wid_s, lds, (GAS bf16_t*)WSP(WS_PROJ), (const GAS int*)PIN(I_POS), PIN(I_QN) + l * 64, PIN(I_KN) + l * 64, PIN(I_SINK) + l * 16);
                XCD_SYNC();
                { pg8::Gemm g{(GAS bf16_t*)WSP(WS_UA), WB(W_QK), T, 2048, 256, DM, 256, 2, 512}; pg8::StaticOrder S; S.init(T, 2048, G, bx);
                  pg8::EpiQK E{(GAS bf16_t*)WSP(WS_PROJ) + C_U, PW, (GAS bf16_t*)WSP(WS_KM), DM}; pg8::gemm_phase(wid_s, lds, g, S, E); }
                XCD_SYNC();
                mlstm_phase(wid_s, lds, (GAS bf16_t*)WSP(WS_PROJ), (GAS bf16_t*)WSP(WS_KM), (const GAS float*)WSP(WS_IF), (GAS float*)WSP(WS_SSQ));
                XCD_SYNC();
                fixup_phase(wid_s, (GAS bf16_t*)WSP(WS_PROJ), (GAS bf16_t*)WSP(WS_UA), (const GAS float*)WSP(WS_SSQ), PIN(I_ONORM) + l * DM, PIN(I_SKIP) + l * DM);
                { pg8::Gemm g{(GAS bf16_t*)WSP(WS_H), WB(W_MERGE), T, 2 * DM, DM, DM, DM, 1 << 30, 0}; pg8::StaticOrder S; S.init(T, 2 * DM, G, bx);
                  pg8::EpiStore2 E{(GAS bf16_t*)WSP(WS_PROJ) + C_U, PW, (GAS bf16_t*)WSP(WS_KM), DM, 4, PIN(I_MERGEB) + l * 2 * DM, 1}; pg8::gemm_phase(wid_s, lds, g, S, E); }
                XCD_SYNC();
                { pg8::Gemm g{(GAS bf16_t*)WSP(WS_PROJ) + C_O, WB(W_PA), T, DM, DM, PW, DM, 1 << 30, 0}; pg8::StaticOrder S; S.init(T, DM, G, bx);
                  pg8::EpiGate<0> E{(GAS bf16_t*)WSP(WS_H), DM, (GAS bf16_t*)WSP(WS_PROJ) + C_U, PW}; pg8::gemm_phase(wid_s, lds, g, S, E); }
                { pg8::Gemm g{(GAS bf16_t*)WSP(WS_PROJ) + C_Q, WB(W_PB), T, DM, DM, PW, DM, 1 << 30, 0}; pg8::StaticOrder S; S.init(T, DM, G, bx);
                  pg8::EpiGate<1> E{(GAS bf16_t*)WSP(WS_H), DM, (GAS bf16_t*)WSP(WS_KM), DM}; pg8::gemm_phase(wid_s, lds, g, S, E); }
                XCD_SYNC();
                { pg8::Gemm g{(GAS bf16_t*)WSP(WS_H), WB(W_WO), T, DM, DM, DM, DM, 1 << 30, 0}; pg8::StaticOrder S; S.init(T, DM, G, bx);
                  pg8::EpiRes E{(const GAS void*)POUT, (GAS void*)POUT, MODL(l) + 5 * 1024, 9216, 1.0f, 0, 0}; pg8::gemm_phase(wid_s, lds, g, S, E); }
                XCD_SYNC();
            }
            if (l == STOP_L && stage == STOP_STAGE) return;
        }
    }
}

extern "C" void kernel_launch(void* const* d_in, const int* in_sizes, int n_in, void* d_out, int out_size, void* d_ws, size_t ws_size, hipStream_t stream) {
    static int grid = 0;
    if (grid == 0) {
        if (n_in != 28 || out_size != T * DM || ws_size < WS_END) { fprintf(stderr, "kernel_launch: unexpected problem (n_in %d, out %d, ws %zu)\n", n_in, out_size, ws_size); grid = -1; return; }
        int dev = 0, cus = 0, per_cu = 0;
        hipGetDevice(&dev);
        hipDeviceGetAttribute(&cus, hipDeviceAttributeMultiprocessorCount, dev);
        hipFuncSetAttribute((const void*)mega_fwd, hipFuncAttributeMaxDynamicSharedMemorySize, LDS_BYTES);
        if (hipOccupancyMaxActiveBlocksPerMultiprocessor(&per_cu, (const void*)mega_fwd, 512, LDS_BYTES) != hipSuccess || per_cu < 1) per_cu = 1;
        (void)hipGetLastError();
        grid = cus * per_cu;
        if (grid < 1) grid = 256;
    }
    if (grid < 0) return;
    Params p{};
    for (int i = 0; i < 28; ++i) p.in[i] = (const float*)d_in[i];
    p.out = (float*)d_out; p.ws = (unsigned char*)d_ws;
    void* args[] = {&p};
    hipError_t e = hipLaunchCooperativeKernel((const void*)mega_fwd, dim3(grid), dim3(512), args, LDS_BYTES, stream);
    if (e != hipSuccess) fprintf(stderr, "cooperative launch failed: %s (grid %d)\n", hipGetErrorString(e), grid);
}
```

```cpp
#include <hip/hip_runtime.h>
#include <hip/hip_cooperative_groups.h>
#include <cstdio>
#include <cstdint>
namespace cg = cooperative_groups;

#define LAS __attribute__((address_space(3)))
#define GAS __attribute__((address_space(1)))
typedef unsigned short bf16_t;
typedef short bf16x8 __attribute__((ext_vector_type(8)));
typedef short bf16x4 __attribute__((ext_vector_type(4)));
typedef float f32x4 __attribute__((ext_vector_type(4)));
typedef float f32x2 __attribute__((ext_vector_type(2)));
typedef unsigned u32x4 __attribute__((ext_vector_type(4)));
typedef unsigned u32x2 __attribute__((ext_vector_type(2)));

constexpr int DM = 1024, NB = 16, SEQ = 2048, T = NB * SEQ, FF = 2816, NIN = 4616;
constexpr int PW = 4608;
constexpr int C_U = 0, C_V = 1024, C_O = 2048, C_Q = 3072, C_K = 4096, C_VA = 4352;
constexpr float EPS = 1e-6f;
constexpr size_t MiB = 1u << 20;
constexpr size_t WS_MOD = 64 * 1024, WS_IF = 2 * MiB, WS_SSQ = 3 * MiB, WS_W = 4 * MiB, WS_H = 24 * MiB, WS_UA = 88 * MiB, WS_KM = 152 * MiB, WS_PROJ = 216 * MiB, WS_END = 504 * MiB;
constexpr size_t W_MIX = 0, W_MERGE = 9 * MiB, W_PA = 13 * MiB, W_PB = 15 * MiB, W_WO = 17 * MiB, W_QK = 19 * MiB;
constexpr size_t W_F1 = 0, W_F2 = 11 * MiB;
constexpr int LDS_BYTES = 147456;
#ifndef STOP_L
#define STOP_L 9
#endif
#ifndef STOP_STAGE
#define STOP_STAGE 9
#endif

__device__ __forceinline__ int opaque_tid(int wid_s) { int t; asm volatile("v_mbcnt_lo_u32_b32 %0, -1, 0\n\tv_mbcnt_hi_u32_b32 %0, -1, %0\n\tv_lshl_or_b32 %0, %1, 6, %0" : "=&v"(t) : "s"(wid_s)); return t; }
#define VBX_LDS_ADDR 147448u
__device__ __forceinline__ int opaque_bx() { int b = *(volatile LAS int*)VBX_LDS_ADDR; b = __builtin_amdgcn_readfirstlane(b); asm volatile("" : "+s"(b)); return b; }
__device__ __forceinline__ int row_cu(int c, int G) { return (G == 256) ? ((c & 7) * 32 + (c >> 3)) : c; }
typedef __bf16 bf16x2_t __attribute__((ext_vector_type(2)));
__device__ __forceinline__ unsigned cvt_pk_bf16(float lo, float hi) { const f32x2 v = {lo, hi}; return __builtin_bit_cast(unsigned, __builtin_convertvector(v, bf16x2_t)); }
__device__ __forceinline__ float bf2f(bf16_t x) { return __uint_as_float((unsigned)x << 16); }
__device__ __forceinline__ float bflo(unsigned x) { return __uint_as_float(x << 16); }
__device__ __forceinline__ float bfhi(unsigned x) { return __uint_as_float(x & 0xffff0000u); }
__device__ __forceinline__ bf16_t f2bf(float f) { return (bf16_t)(cvt_pk_bf16(f, 0.f) & 0xffffu); }
__device__ __forceinline__ float fexp(float x) { return __builtin_amdgcn_exp2f(x * 1.44269504088896f); }
__device__ __forceinline__ float fsigmoid(float x) { return __builtin_amdgcn_rcpf(1.0f + fexp(-x)); }
__device__ __forceinline__ float fsilu(float x) { return x * fsigmoid(x); }
__device__ __forceinline__ float shx(float v, int lane, int o) { return __int_as_float(__builtin_amdgcn_ds_bpermute((lane ^ o) << 2, __float_as_int(v))); }
__device__ __forceinline__ float shi(float v, int idx) { return __int_as_float(__builtin_amdgcn_ds_bpermute(idx << 2, __float_as_int(v))); }
__device__ __forceinline__ float wave_sum(float v, int lane) {
#pragma unroll
    for (int o = 1; o < 64; o <<= 1) v += shx(v, lane, o);
    return v;
}
#define DPP_F(old_, src_, ctrl_, rm_) __int_as_float(__builtin_amdgcn_update_dpp(__float_as_int(old_), __float_as_int(src_), (ctrl_), (rm_), 0xf, false))
__device__ __forceinline__ float scan_sum64(float v) {
    v += DPP_F(0.f, v, 0x111, 0xf); v += DPP_F(0.f, v, 0x112, 0xf); v += DPP_F(0.f, v, 0x114, 0xf); v += DPP_F(0.f, v, 0x118, 0xf);
    v += DPP_F(0.f, v, 0x142, 0xa); v += DPP_F(0.f, v, 0x143, 0xc); return v; }
__device__ __forceinline__ float scan_max64(float v) {
    const float ninf = -__builtin_inff();
    v = fmaxf(v, DPP_F(ninf, v, 0x111, 0xf)); v = fmaxf(v, DPP_F(ninf, v, 0x112, 0xf)); v = fmaxf(v, DPP_F(ninf, v, 0x114, 0xf)); v = fmaxf(v, DPP_F(ninf, v, 0x118, 0xf));
    v = fmaxf(v, DPP_F(ninf, v, 0x142, 0xa)); v = fmaxf(v, DPP_F(ninf, v, 0x143, 0xc)); return v; }
__device__ const float INV_FREQ[32] = {
1.0000000000e+00f, 7.4989420933e-01f, 5.6234132519e-01f, 4.2169650343e-01f, 3.1622776602e-01f, 2.3713737057e-01f, 1.7782794100e-01f, 1.3335214322e-01f,
1.0000000000e-01f, 7.4989420933e-02f, 5.6234132519e-02f, 4.2169650343e-02f, 3.1622776602e-02f, 2.3713737057e-02f, 1.7782794100e-02f, 1.3335214322e-02f,
1.0000000000e-02f, 7.4989420933e-03f, 5.6234132519e-03f, 4.2169650343e-03f, 3.1622776602e-03f, 2.3713737057e-03f, 1.7782794100e-03f, 1.3335214322e-03f,
1.0000000000e-03f, 7.4989420933e-04f, 5.6234132519e-04f, 4.2169650343e-04f, 3.1622776602e-04f, 2.3713737057e-04f, 1.7782794100e-04f, 1.3335214322e-04f};
#define MFMA16(a, b, c) __builtin_amdgcn_mfma_f32_16x16x32_bf16((a), (b), (c), 0, 0, 0)

namespace pg8 {
constexpr int BM = 256, BK = 64, HALF = 128, HTB = HALF * BK * 2, STAGE_BYTES = 8 * HTB, NXCD = 8, WGM = 8;
__host__ __device__ __forceinline__ int lds_byte(int r, int c) { const int st = (r >> 4) * 2 + (c >> 5), rr = r & 15, cc = c & 31, ob = rr * 64 + cc * 2; return st * 1024 + (ob ^ (((ob >> 9) & 1) << 5)); }
__host__ __device__ __forceinline__ void stage_rc(int b, int& R, int& C) { const int st = b / 1024, sb = b % 1024, swz = sb ^ (((sb >> 9) & 1) << 5); R = (st >> 1) * 16 + swz / 64; C = (st & 1) * 32 + (swz % 64) / 2; }
__host__ __device__ __forceinline__ int perm32(int rho) { const int n = rho >> 4, i = rho & 15; return 8 * (i >> 2) + 4 * n + (i & 3); }

struct Unit { int pm, pn; };
struct Gemm { const GAS bf16_t* A; const GAS bf16_t* Bt; int M, N, K, lda, ldb, agrp; size_t agoff; };

struct StaticOrder {
    int nM, nN, nwg, G, c;
    __host__ __device__ void init(int M, int N, int G_, int c_) { nM = M / BM; nN = N / BM; nwg = nM * nN; G = G_; c = c_; }
    __host__ __device__ bool next(int i, Unit& u) const {
        const long L = (long)i * G + c; if (L >= nwg) return false;
        int wgid = (int)L; { const int q = nwg / NXCD, r = nwg % NXCD, xcd = wgid % NXCD, off = wgid / NXCD; wgid = (xcd < r ? xcd * (q + 1) : r * (q + 1) + (xcd - r) * q) + off; }
        const int nig = WGM * nN, gid = wgid / nig, fm = gid * WGM, gsz = (nM - fm) < WGM ? (nM - fm) : WGM;
        u.pm = fm + ((wgid % nig) % gsz); u.pn = (wgid % nig) / gsz; return true;
    }
};

typedef f32x4 AccT[2][2][4][2];

struct EpiStore2 {
    static constexpr bool PERM = true;
    GAS bf16_t* O0; int ld0; GAS bf16_t* O1; int ld1; int split; const GAS float* bias; int act;
    __device__ __forceinline__ void operator()(const AccT& acc, const Unit& u, int wr, int wc, int fr, int fq) const {
        const int row0 = u.pm * BM + wr * 64 + fr;
        GAS bf16_t* base; int ld, ct;
        if (u.pn < split) { base = O0; ld = ld0; ct = u.pn; } else { base = O1; ld = ld1; ct = u.pn - split; }
        const int col0 = ct * BM + wc * 32 + 8 * fq, bcol0 = u.pn * BM + wc * 32 + 8 * fq;
#pragma unroll
        for (int bj = 0; bj < 2; ++bj) {
            f32x4 b0 = (f32x4){0.f, 0.f, 0.f, 0.f}, b1 = b0;
            if (act) { b0 = *(const GAS f32x4*)(bias + bcol0 + bj * HALF) * -1.4426950408889634f; b1 = *(const GAS f32x4*)(bias + bcol0 + bj * HALF + 4) * -1.4426950408889634f; }
#pragma unroll
            for (int ai = 0; ai < 2; ++ai)
#pragma unroll
                for (int m = 0; m < 4; ++m) {
                    f32x4 v0 = acc[ai][bj][m][0], v1 = acc[ai][bj][m][1];
                    if (act) { v0 += b0; v1 += b1;
#pragma unroll
                        for (int e = 0; e < 4; ++e) { v0[e] = __builtin_amdgcn_rcpf(1.0f + __builtin_amdgcn_exp2f(v0[e])); v1[e] = __builtin_amdgcn_rcpf(1.0f + __builtin_amdgcn_exp2f(v1[e])); } }
                    u32x4 w; w.x = cvt_pk_bf16(v0[0], v0[1]); w.y = cvt_pk_bf16(v0[2], v0[3]); w.z = cvt_pk_bf16(v1[0], v1[1]); w.w = cvt_pk_bf16(v1[2], v1[3]);
                    *(GAS u32x4*)(base + (size_t)(row0 + ai * HALF + m * 16) * ld + col0 + bj * HALF) = w;
                }
        }
    }
};
struct EpiQK {
    static constexpr bool PERM = true;
    GAS bf16_t* O0; int ld0; GAS bf16_t* O1; int ld1;
    __device__ __forceinline__ void operator()(const AccT& acc, const Unit& u, int wr, int wc, int fr, int fq) const {
        const int row0 = u.pm * BM + wr * 64 + fr, hd = u.pn >> 1;
        GAS bf16_t* base = (u.pn & 1) ? O1 : O0; const int ld = (u.pn & 1) ? ld1 : ld0;
        const int col0 = hd * BM + wc * 32 + 8 * fq;
#pragma unroll
        for (int bj = 0; bj < 2; ++bj)
#pragma unroll
            for (int ai = 0; ai < 2; ++ai)
#pragma unroll
                for (int m = 0; m < 4; ++m) {
                    const f32x4 v0 = acc[ai][bj][m][0], v1 = acc[ai][bj][m][1];
                    u32x4 w; w.x = cvt_pk_bf16(v0[0], v0[1]); w.y = cvt_pk_bf16(v0[2], v0[3]); w.z = cvt_pk_bf16(v1[0], v1[1]); w.w = cvt_pk_bf16(v1[2], v1[3]);
                    *(GAS u32x4*)(base + (size_t)(row0 + ai * HALF + m * 16) * ld + col0 + bj * HALF) = w;
                }
    }
};
struct EpiSwiGLU {
    static constexpr bool PERM = true;
    GAS bf16_t* O; int ldc;
    __device__ __forceinline__ void operator()(const AccT& acc, const Unit& u, int wr, int wc, int fr, int fq) const {
        const int row0 = u.pm * BM + wr * 64 + fr, col0 = u.pn * 128 + wc * 32 + 8 * fq;
#pragma unroll
        for (int ai = 0; ai < 2; ++ai)
#pragma unroll
            for (int m = 0; m < 4; ++m) {
                const f32x4 a0 = acc[ai][0][m][0], a1 = acc[ai][0][m][1], g0 = acc[ai][1][m][0], g1 = acc[ai][1][m][1];
                f32x4 r0, r1;
#pragma unroll
                for (int e = 0; e < 4; ++e) { r0[e] = a0[e] * g0[e] * __builtin_amdgcn_rcpf(1.0f + __builtin_amdgcn_exp2f(a0[e])); r1[e] = a1[e] * g1[e] * __builtin_amdgcn_rcpf(1.0f + __builtin_amdgcn_exp2f(a1[e])); }
                u32x4 w; w.x = cvt_pk_bf16(r0[0], r0[1]); w.y = cvt_pk_bf16(r0[2], r0[3]); w.z = cvt_pk_bf16(r1[0], r1[1]); w.w = cvt_pk_bf16(r1[2], r1[3]);
                *(GAS u32x4*)(O + (size_t)(row0 + ai * HALF + m * 16) * ldc + col0) = w;
            }
    }
};
template <int MODE> struct EpiGate {
    static constexpr bool PERM = true;
    GAS bf16_t* O; int ldo; const GAS bf16_t* Gt; int ldg;
    __device__ __forceinline__ void operator()(const AccT& acc, const Unit& u, int wr, int wc, int fr, int fq) const {
        const int row0 = u.pm * BM + wr * 64 + fr, col0 = u.pn * BM + wc * 32 + 8 * fq;
#pragma unroll
        for (int bj = 0; bj < 2; ++bj)
#pragma unroll
            for (int ai = 0; ai < 2; ++ai)
#pragma unroll
                for (int m = 0; m < 4; ++m) {
                    const size_t r = (size_t)(row0 + ai * HALF + m * 16);
                    const u32x4 gv = *(const GAS u32x4*)(Gt + r * ldg + col0 + bj * HALF);
                    GAS bf16_t* op = O + r * ldo + col0 + bj * HALF;
                    f32x4 v0 = acc[ai][bj][m][0], v1 = acc[ai][bj][m][1];
                    v0[0] *= bflo(gv.x); v0[1] *= bfhi(gv.x); v0[2] *= bflo(gv.y); v0[3] *= bfhi(gv.y);
                    v1[0] *= bflo(gv.z); v1[1] *= bfhi(gv.z); v1[2] *= bflo(gv.w); v1[3] *= bfhi(gv.w);
                    if (MODE == 1) { const u32x4 tv = *(const GAS u32x4*)op;
                        v0[0] += bflo(tv.x); v0[1] += bfhi(tv.x); v0[2] += bflo(tv.y); v0[3] += bfhi(tv.y);
                        v1[0] += bflo(tv.z); v1[1] += bfhi(tv.z); v1[2] += bflo(tv.w); v1[3] += bfhi(tv.w); }
                    u32x4 w; w.x = cvt_pk_bf16(v0[0], v0[1]); w.y = cvt_pk_bf16(v0[2], v0[3]); w.z = cvt_pk_bf16(v1[0], v1[1]); w.w = cvt_pk_bf16(v1[2], v1[3]);
                    *(GAS u32x4*)op = w;
                }
    }
};
struct EpiRes {
    static constexpr bool PERM = true;
    const GAS void* xin; GAS void* out; const GAS float* gate; int gstride; float scale; int in_f32, out_f32;
    __device__ __forceinline__ void operator()(const AccT& acc, const Unit& u, int wr, int wc, int fr, int fq) const {
        const int row0 = u.pm * BM + wr * 64 + fr, col0 = u.pn * BM + wc * 32 + 8 * fq;
        const GAS float* gp = gate + (size_t)(u.pm >> 3) * gstride;
#pragma unroll
        for (int bj = 0; bj < 2; ++bj) {
            const f32x4 g0 = *(const GAS f32x4*)(gp + col0 + bj * HALF) * scale, g1 = *(const GAS f32x4*)(gp + col0 + bj * HALF + 4) * scale;
#pragma unroll
            for (int ai = 0; ai < 2; ++ai)
#pragma unroll
                for (int m = 0; m < 4; ++m) {
                    const size_t off = (size_t)(row0 + ai * HALF + m * 16) * DM + col0 + bj * HALF;
                    f32x4 x0, x1;
                    if (in_f32) { x0 = *(const GAS f32x4*)((const GAS float*)xin + off); x1 = *(const GAS f32x4*)((const GAS float*)xin + off + 4); }
                    else { const u32x4 v = *(const GAS u32x4*)((const GAS bf16_t*)xin + off);
                        x0 = (f32x4){bflo(v.x), bfhi(v.x), bflo(v.y), bfhi(v.y)}; x1 = (f32x4){bflo(v.z), bfhi(v.z), bflo(v.w), bfhi(v.w)}; }
                    const f32x4 y0 = x0 + g0 * acc[ai][bj][m][0], y1 = x1 + g1 * acc[ai][bj][m][1];
                    if (out_f32) { *(GAS f32x4*)((GAS float*)out + off) = y0; *(GAS f32x4*)((GAS float*)out + off + 4) = y1; }
                    else { u32x4 w; w.x = cvt_pk_bf16(y0[0], y0[1]); w.y = cvt_pk_bf16(y0[2], y0[3]); w.z = cvt_pk_bf16(y1[0], y1[1]); w.w = cvt_pk_bf16(y1[2], y1[3]);
                        *(GAS u32x4*)((GAS bf16_t*)out + off) = w; }
                }
        }
    }
};

template <class Epi>
__device__ __forceinline__ void gemm_phase(int wid_s, LAS unsigned char* lds, const Gemm g, const StaticOrder& S, const Epi& E) {
    const int tid = opaque_tid(wid_s), wid = __builtin_amdgcn_readfirstlane(tid >> 6), lane = tid & 63, wr = wid >> 2, wc = wid & 3, fr = lane & 15, fq = lane >> 4;
    const int K = g.K, nt = K / BK;
    unsigned voffA[2], voffB[2];
#pragma unroll
    for (int i = 0; i < 2; ++i) { int R, C; stage_rc(tid * 16 + i * 8192, R, C); const int Rb = Epi::PERM ? ((R & ~31) + perm32(R & 31)) : R;
        voffA[i] = (unsigned)(R * g.lda + C) * 2u; voffB[i] = (unsigned)(Rb * g.ldb + C) * 2u; }
    const size_t kstep = (size_t)(BK * 2);
    const size_t hsA = (size_t)HALF * g.lda * 2, hsB = (size_t)HALF * g.ldb * 2;
    const size_t tsA = 2 * hsA, tsB = 2 * hsB;
    const unsigned ldsw = (unsigned)wid * 1024u;
    const int aoff = lds_byte(wr * 64 + fr, fq * 8), boff = lds_byte(wc * 32 + fr, fq * 8);
#define PG8_SA(b, h) (((b) * 2 + (h)) * HTB)
#define PG8_SB(b, h) ((4 + (b) * 2 + (h)) * HTB)
#define PG8_STAGE(bufoff, gbase, voff) do { _Pragma("unroll") for (int _i = 0; _i < 2; ++_i) \
        __builtin_amdgcn_global_load_lds((const GAS unsigned*)((const GAS char*)(gbase) + (voff)[_i]), (LAS unsigned*)(lds + (bufoff) + ldsw + _i * 8192), 16, 0, 0); } while (0)
#define PG8_LDA(dst, b, h) do { _Pragma("unroll") for (int m = 0; m < 4; ++m) _Pragma("unroll") for (int k = 0; k < 2; ++k) dst[m][k] = *(const LAS bf16x8*)(lds + PG8_SA(b, h) + aoff + m * 2048 + k * 1024); } while (0)
#define PG8_LDB(dst, b, h) do { _Pragma("unroll") for (int n = 0; n < 2; ++n) _Pragma("unroll") for (int k = 0; k < 2; ++k) dst[n][k] = *(const LAS bf16x8*)(lds + PG8_SB(b, h) + boff + n * 2048 + k * 1024); } while (0)
#define PG8_MMA(ai, bj, At, Bt) do { __builtin_amdgcn_s_setprio(1); _Pragma("unroll") for (int m = 0; m < 4; ++m) _Pragma("unroll") for (int n = 0; n < 2; ++n) _Pragma("unroll") for (int k = 0; k < 2; ++k) \
        acc[ai][bj][m][n] = __builtin_amdgcn_mfma_f32_16x16x32_bf16(Bt[n][k], At[m][k], acc[ai][bj][m][n], 0, 0, 0); __builtin_amdgcn_s_setprio(0); } while (0)
#define PG8_WAIT_V(n) asm volatile("s_waitcnt vmcnt(" #n ")" ::: "memory")
#define PG8_WAIT_L(n) asm volatile("s_waitcnt lgkmcnt(" #n ")" ::: "memory")
#define PG8_BAR __builtin_amdgcn_s_barrier()
#define PG8_SCHED __builtin_amdgcn_sched_barrier(0)
#define PG8_ABASE(u) ((const GAS char*)g.A + (size_t)(u).pm * tsA + (size_t)((u).pn / g.agrp) * g.agoff)
    Unit cur, nxt; int ui = 0;
    if (!S.next(0, cur)) return;
    f32x4 acc[2][2][4][2];
#pragma unroll
    for (int a = 0; a < 2; ++a)
#pragma unroll
        for (int b = 0; b < 2; ++b)
#pragma unroll
            for (int m = 0; m < 4; ++m)
#pragma unroll
                for (int n = 0; n < 2; ++n) acc[a][b][m][n] = (f32x4){0.f, 0.f, 0.f, 0.f};
    bf16x8 At[4][2], B0[2][2], B1[2][2];
    const GAS char* cA = PG8_ABASE(cur); const GAS char* cB = (const GAS char*)g.Bt + (size_t)cur.pn * tsB;
    PG8_STAGE(PG8_SB(0, 0), cB, voffB); PG8_STAGE(PG8_SB(0, 1), cB + hsB, voffB); PG8_STAGE(PG8_SA(0, 0), cA, voffA); PG8_STAGE(PG8_SA(0, 1), cA + hsA, voffA);
    if (wr == 1) PG8_BAR;
    PG8_WAIT_V(2); PG8_BAR;
    PG8_STAGE(PG8_SB(1, 0), cB + kstep, voffB); PG8_STAGE(PG8_SA(1, 0), cA + kstep, voffA); PG8_STAGE(PG8_SB(1, 1), cB + hsB + kstep, voffB);
    PG8_WAIT_V(6); PG8_BAR;
    for (;;) {
        const bool has_next = S.next(ui + 1, nxt);
        const GAS char* nA = has_next ? PG8_ABASE(nxt) : cA; const GAS char* nB = has_next ? (const GAS char*)g.Bt + (size_t)nxt.pn * tsB : cB;
        for (int t = 0; t < nt; t += 2) {
            const bool last = (t == nt - 2);
            const GAS char* a1 = cA + (size_t)(t + 1) * kstep;
            const GAS char* a2 = last ? nA : cA + (size_t)(t + 2) * kstep; const GAS char* b2 = last ? nB : cB + (size_t)(t + 2) * kstep;
            const GAS char* a3 = a2 + kstep; const GAS char* b3 = b2 + kstep;
            PG8_LDB(B0, 0, 0); PG8_LDB(B1, 0, 1); PG8_SCHED; PG8_LDA(At, 0, 0); PG8_STAGE(PG8_SA(1, 1), a1 + hsA, voffA);
            PG8_WAIT_V(8); PG8_WAIT_L(0); PG8_BAR; PG8_MMA(0, 0, At, B0); PG8_MMA(0, 1, At, B1); PG8_BAR; PG8_SCHED;
            PG8_LDA(At, 0, 1); PG8_STAGE(PG8_SB(0, 0), b2, voffB); PG8_STAGE(PG8_SB(0, 1), b2 + hsB, voffB); PG8_STAGE(PG8_SA(0, 0), a2, voffA);
            PG8_WAIT_V(8); PG8_WAIT_L(0); PG8_BAR; PG8_MMA(1, 0, At, B0); PG8_MMA(1, 1, At, B1); PG8_BAR; PG8_SCHED;
            PG8_LDB(B0, 1, 0); PG8_LDB(B1, 1, 1); PG8_SCHED; PG8_LDA(At, 1, 0); PG8_STAGE(PG8_SA(0, 1), a2 + hsA, voffA);
            PG8_WAIT_V(8); PG8_WAIT_L(0); PG8_BAR; PG8_MMA(0, 0, At, B0); PG8_MMA(0, 1, At, B1); PG8_BAR; PG8_SCHED;
            PG8_LDA(At, 1, 1); PG8_STAGE(PG8_SB(1, 0), b3, voffB); PG8_STAGE(PG8_SB(1, 1), b3 + hsB, voffB); PG8_STAGE(PG8_SA(1, 0), a3, voffA);
            PG8_WAIT_V(8); PG8_WAIT_L(0); PG8_BAR; PG8_MMA(1, 0, At, B0); PG8_MMA(1, 1, At, B1); PG8_BAR; PG8_SCHED;
        }
        if (wr == 0) PG8_BAR;
        { const int le = opaque_tid(wid_s) & 63; E(acc, cur, wr, wc, le & 15, le >> 4); }
        if (!has_next) break;
#pragma unroll
        for (int a = 0; a < 2; ++a)
#pragma unroll
            for (int b = 0; b < 2; ++b)
#pragma unroll
                for (int m = 0; m < 4; ++m)
#pragma unroll
                    for (int n = 0; n < 2; ++n) acc[a][b][m][n] = (f32x4){0.f, 0.f, 0.f, 0.f};
        cur = nxt; cA = nA; cB = nB; ++ui;
        if (wr == 1) PG8_BAR;
    }
    PG8_WAIT_V(0);
    PG8_BAR;
#undef PG8_SA
#undef PG8_SB
#undef PG8_STAGE
#undef PG8_LDA
#undef PG8_LDB
#undef PG8_MMA
#undef PG8_WAIT_V
#undef PG8_WAIT_L
#undef PG8_BAR
#undef PG8_SCHED
#undef PG8_ABASE
}
}

struct Params { const float* in[28]; float* out; unsigned char* ws; };
enum { I_X = 0, I_C, I_POS, I_ADAW, I_ADAB, I_F1N, I_F1WI, I_F1WO, I_MIXN, I_MIXW, I_GATEB, I_CONVW, I_CONVB, I_WQ, I_WK, I_ONORM, I_SKIP, I_QN, I_KN, I_SINK,
       I_PA, I_PB, I_MERGEW, I_MERGEB, I_WOUT, I_F2N, I_F2WI, I_F2WO };

__device__ __forceinline__ void cvt_item(const GAS float* W, int Nsrc, int K, GAS bf16_t* WT, int nblk, int item, int mode, float scale, LAS float* scr, int lane) {
    const int kb = item / nblk, nb = item % nblk, k0 = 64 * kb, n0 = 32 * nb;
    const int n = n0 + (lane & 31);
    const float scl = (mode == 2) ? ((n & 128) ? -0.6931471805599453f : -1.4426950408889634f) : scale;
    const int sc = mode == 0 ? n : (mode == 1 ? (n < 3072 ? n : n + 8) : (((n & 128) ? FF : 0) + (n >> 8) * 128 + (n & 127)));
    float tmpw[32];
#pragma unroll
    for (int i = 0; i < 32; ++i) tmpw[i] = W[(size_t)(k0 + 2 * i + (lane >> 5)) * Nsrc + sc];
#pragma unroll
    for (int i = 0; i < 32; ++i) scr[(2 * i + (lane >> 5)) * 33 + (lane & 31)] = tmpw[i] * scl;
    asm volatile("s_waitcnt lgkmcnt(0)" ::: "memory");
    const int c = lane & 7;
#pragma unroll
    for (int j = 0; j < 4; ++j) { const int nn = (lane >> 3) + 8 * j; const LAS float* s = scr + (8 * c) * 33 + nn;
        u32x4 o; o.x = cvt_pk_bf16(s[0 * 33], s[1 * 33]); o.y = cvt_pk_bf16(s[2 * 33], s[3 * 33]); o.z = cvt_pk_bf16(s[4 * 33], s[5 * 33]); o.w = cvt_pk_bf16(s[6 * 33], s[7 * 33]);
        *(GAS u32x4*)(WT + (size_t)(n0 + nn) * K + k0 + 8 * c) = o; }
    asm volatile("s_waitcnt lgkmcnt(0)" ::: "memory");
}
struct CvtJob { const GAS float* W; int Nsrc, K, Ndst; GAS bf16_t* WT; int mode; float scale; };
__device__ __forceinline__ void cvt_run(const CvtJob& j, int& base, int gw, int NGW, LAS float* scr, int lane) {
    const int nblk = j.Ndst / 32, items = (j.K / 64) * nblk;
    int it = gw - (base % NGW); if (it < 0) it += NGW;
    for (; it < items; it += NGW) cvt_item(j.W, j.Nsrc, j.K, j.WT, nblk, it, j.mode, j.scale, scr, lane);
    base += items;
}

__device__ __forceinline__ void mod_phase(int wid_s, LAS unsigned char* lds, const GAS float* c, const GAS float* adaw, const GAS float* adab, GAS float* MOD) {
    const int tid = opaque_tid(wid_s), w = tid >> 6, lane = tid & 63;
    LAS float* sc = (LAS float*)lds;
    LAS float* red = (LAS float*)(lds + 65536);
    for (int i = tid; i < NB * DM; i += 512) sc[i] = fsilu(c[i]);
    __syncthreads();
    for (int item = opaque_bx(); item < 256; item += gridDim.x) {
        const int l = item >> 7, j0 = (item & 127) * 72;
        const GAS float* wp = adaw + (size_t)l * DM * 9216 + j0 + lane;
        const bool has2 = lane < 8;
        float acc[16], acc2[16];
#pragma unroll
        for (int b = 0; b < 16; ++b) { acc[b] = 0.f; acc2[b] = 0.f; }
#pragma unroll 2
        for (int k = w * 128; k < w * 128 + 128; k += 4) {
            const float w0 = wp[(size_t)k * 9216], w1 = wp[(size_t)(k + 1) * 9216], w2 = wp[(size_t)(k + 2) * 9216], w3 = wp[(size_t)(k + 3) * 9216];
            float x0 = 0.f, x1 = 0.f, x2 = 0.f, x3 = 0.f;
            if (has2) { x0 = wp[(size_t)k * 9216 + 64]; x1 = wp[(size_t)(k + 1) * 9216 + 64]; x2 = wp[(size_t)(k + 2) * 9216 + 64]; x3 = wp[(size_t)(k + 3) * 9216 + 64]; }
#pragma unroll
            for (int b = 0; b < 16; ++b) { const f32x4 sv = *(const LAS f32x4*)(sc + b * DM + k);
                acc[b] += sv[0] * w0 + sv[1] * w1 + sv[2] * w2 + sv[3] * w3; acc2[b] += sv[0] * x0 + sv[1] * x1 + sv[2] * x2 + sv[3] * x3; }
        }
#pragma unroll
        for (int b = 0; b < 16; ++b) { red[(w * 16 + b) * 72 + lane] = acc[b]; if (has2) red[(w * 16 + b) * 72 + 64 + lane] = acc2[b]; }
        __syncthreads();
        for (int o = tid; o < 16 * 72; o += 512) { const int b = o / 72, j = o % 72; float sm = adab[l * 9216 + j0 + j];
#pragma unroll
            for (int ww = 0; ww < 8; ++ww) sm += red[(ww * 16 + b) * 72 + j];
            MOD[((size_t)l * NB + b) * 9216 + j0 + j] = sm; }
        __syncthreads();
    }
}

template <bool GATES>
__device__ __forceinline__ void modulate_phase(int wid_s, LAS unsigned char* lds, const GAS void* xin, int in_f32, GAS bf16_t* xcopy, const GAS float* nw, const GAS float* modl, int shc, GAS bf16_t* H,
                                               const GAS float* mixw, const GAS float* gateb, GAS float* IF, GAS float* SSQ) {
    const int tid = opaque_tid(wid_s), w = tid >> 6, lane = tid & 63;
    LAS float* Wg = (LAS float*)lds;
    if (GATES) { for (int i = tid; i < 8192; i += 512) { const int cc = i >> 3, gi = i & 7; Wg[gi * 1024 + cc] = mixw[(size_t)cc * NIN + 3072 + gi]; } __syncthreads(); }
    for (int blk = row_cu(opaque_bx(), gridDim.x); blk < T / 128; blk += gridDim.x) {
        const int b = blk >> 4;
        const GAS float* shp = modl + (size_t)b * 9216 + shc * 1024; const GAS float* scp = shp + 1024;
        f32x4 Af[4], Sf[4];
#pragma unroll
        for (int j = 0; j < 4; ++j) { const int cc = 4 * lane + 256 * j; const f32x4 n4 = *(const GAS f32x4*)(nw + cc), s4 = *(const GAS f32x4*)(scp + cc); Af[j] = n4 * (s4 + 1.0f); Sf[j] = *(const GAS f32x4*)(shp + cc); }
        if (GATES) SSQ[blk * 512 + tid] = 0.f;
        for (int rr = 0; rr < 16; ++rr) {
            const int row = blk * 128 + w * 16 + rr;
            f32x4 v[4]; float ss = 0.f;
            if (in_f32) { const GAS f32x4* xr = (const GAS f32x4*)((const GAS float*)xin + (size_t)row * DM) + lane;
#pragma unroll
                for (int j = 0; j < 4; ++j) v[j] = xr[64 * j]; }
            else { const GAS u32x2* xr = (const GAS u32x2*)((const GAS bf16_t*)xin + (size_t)row * DM) + lane;
#pragma unroll
                for (int j = 0; j < 4; ++j) { const u32x2 uv = xr[64 * j]; v[j] = (f32x4){bflo(uv.x), bfhi(uv.x), bflo(uv.y), bfhi(uv.y)};
                    if (xcopy) *((GAS u32x2*)(xcopy + (size_t)row * DM) + lane + 64 * j) = uv; } }
#pragma unroll
            for (int j = 0; j < 4; ++j) ss += (v[j][0] * v[j][0] + v[j][1] * v[j][1]) + (v[j][2] * v[j][2] + v[j][3] * v[j][3]);
            const float rstd = 1.0f / sqrtf(wave_sum(ss, lane) * (1.0f / DM) + EPS);
#pragma unroll
            for (int j = 0; j < 4; ++j) { v[j] = v[j] * rstd * Af[j] + Sf[j];
                u32x2 o; o.x = cvt_pk_bf16(v[j][0], v[j][1]); o.y = cvt_pk_bf16(v[j][2], v[j][3]);
                *((GAS u32x2*)(H + (size_t)row * DM) + lane + 64 * j) = o; }
            if (GATES) {
                float ga[8];
#pragma unroll
                for (int gi = 0; gi < 8; ++gi) { float a = 0.f;
#pragma unroll
                    for (int j = 0; j < 4; ++j) { const f32x4 wv = *(const LAS f32x4*)(Wg + gi * 1024 + 4 * lane + 256 * j); a += (v[j][0] * wv[0] + v[j][1] * wv[1]) + (v[j][2] * wv[2] + v[j][3] * wv[3]); }
                    ga[gi] = wave_sum(a, lane); }
                float mine = 0.f;
#pragma unroll
                for (int gi = 0; gi < 8; ++gi) mine = (lane == gi) ? ga[gi] : mine;
                if (lane < 8) { float pre = mine + gateb[lane];
                    if (lane >= 4) pre = fminf(pre, 0.f) - 0.6931471805599453f * __builtin_amdgcn_logf(1.0f + fexp(-fabsf(pre)));
                    IF[(size_t)row * 8 + lane] = pre; }
            }
        }
    }
}

__device__ __forceinline__ void conv_phase(int wid_s, const GAS bf16_t* PROJ, const GAS float* cw, const GAS float* cb, GAS bf16_t* UA) {
    const int tid = opaque_tid(wid_s), cg8 = (tid & 127) * 8, rg = tid >> 7;
    float wt[4][8], bb[8];
#pragma unroll
    for (int j = 0; j < 4; ++j)
#pragma unroll
        for (int e = 0; e < 8; ++e) wt[j][e] = cw[j * 1024 + cg8 + e];
#pragma unroll
    for (int e = 0; e < 8; ++e) bb[e] = cb[cg8 + e];
    const int G_ = gridDim.x, rc_ = row_cu(opaque_bx(), G_), per_ = (G_ == 256) ? 2 : 1;
    for (int it_ = rc_ * per_; it_ < T / 64; it_ += (it_ % per_ == per_ - 1) ? (G_ * per_ - (per_ - 1)) : 1) {
        const int item = it_;
        const int r0 = item * 64 + rg * 16;
        float p[3][8];
#pragma unroll
        for (int j = 0; j < 3; ++j) { const int tr = r0 - 3 + j; u32x4 v = (u32x4){0u, 0u, 0u, 0u};
            if ((r0 & (SEQ - 1)) - 3 + j >= 0) v = *(const GAS u32x4*)(PROJ + (size_t)tr * PW + C_U + cg8);
            p[j][0] = bflo(v.x); p[j][1] = bfhi(v.x); p[j][2] = bflo(v.y); p[j][3] = bfhi(v.y); p[j][4] = bflo(v.z); p[j][5] = bfhi(v.z); p[j][6] = bflo(v.w); p[j][7] = bfhi(v.w); }
#pragma unroll 8
        for (int rr = 0; rr < 16; ++rr) {
            const u32x4 v = *(const GAS u32x4*)(PROJ + (size_t)(r0 + rr) * PW + C_U + cg8);
            float cu[8] = {bflo(v.x), bfhi(v.x), bflo(v.y), bfhi(v.y), bflo(v.z), bfhi(v.z), bflo(v.w), bfhi(v.w)};
            float o[8];
#pragma unroll
            for (int e = 0; e < 8; ++e) { o[e] = fsilu(wt[0][e] * p[0][e] + wt[1][e] * p[1][e] + wt[2][e] * p[2][e] + wt[3][e] * cu[e] + bb[e]); p[0][e] = p[1][e]; p[1][e] = p[2][e]; p[2][e] = cu[e]; }
            u32x4 w; w.x = cvt_pk_bf16(o[0], o[1]); w.y = cvt_pk_bf16(o[2], o[3]); w.z = cvt_pk_bf16(o[4], o[5]); w.w = cvt_pk_bf16(o[6], o[7]);
            *(GAS u32x4*)(UA + (size_t)(r0 + rr) * DM + cg8) = w;
        }
    }
}

__device__ __forceinline__ void swa_phase(int wid_s, LAS unsigned char* lds, GAS bf16_t* PROJ, const GAS int* pos, const GAS float* qn, const GAS float* kn, const GAS float* sinks) {
    const int tid = opaque_tid(wid_s), w = tid >> 6, lane = tid & 63, fr = lane & 15, kq = lane >> 4;
    LAS bf16_t* Qs = (LAS bf16_t*)lds;
    LAS bf16_t* Ks = Qs + 256 * 72;
    LAS bf16_t* Vt = Ks + 192 * 72;
    LAS int* posl = (LAS int*)(Vt + 64 * 200);
    LAS float* nrm = (LAS float*)(posl + 256);
    if (tid < 64) nrm[tid] = qn[tid]; else if (tid < 128) nrm[tid] = kn[tid - 64];
    const int G_ = gridDim.x, rc_ = row_cu(opaque_bx(), G_), per_ = (G_ == 256) ? 8 : 1;
    u32x4 pk[3], pv[3]; int ppos = 0;
#define SWA_FETCH(u_) do { const int t_ = opaque_tid(wid_s); const int b_ = (u_) >> 7, n_ = ((u_) >> 2) & 31, hk_ = (u_) & 3, kc_ = n_ >= 2 ? n_ - 2 : 0, nk_ = (n_ - kc_ + 1) * 64; \
        const int tq_ = b_ * SEQ + n_ * 64, tk_ = b_ * SEQ + kc_ * 64; \
        _Pragma("unroll") for (int i = 0; i < 3; ++i) { const int p = t_ + 512 * i; \
            if (p < nk_ * 8) { const int r = p >> 3, pc = p & 7; \
                pk[i] = *(const GAS u32x4*)(PROJ + (size_t)(tk_ + r) * PW + C_K + hk_ * 64 + pc * 8); \
                pv[i] = *(const GAS u32x4*)(PROJ + (size_t)(tk_ + r) * PW + C_VA + hk_ * 64 + pc * 8); } } \
        if (t_ < 64) ppos = pos[tq_ + t_]; else if (t_ < 64 + nk_) ppos = pos[tk_ + t_ - 64]; } while (0)
    const int unit0_ = rc_ * per_;
    if (unit0_ < NB * 32 * 4) SWA_FETCH(unit0_);
    for (int unit = unit0_; unit < NB * 32 * 4; ) {
        const int unit_next = unit + ((unit % per_ == per_ - 1) ? (G_ * per_ - (per_ - 1)) : 1);
        const int tid = opaque_tid(wid_s), w = tid >> 6, lane = tid & 63, fr = lane & 15, kq = lane >> 4;
        const int b = unit >> 7, n = (unit >> 2) & 31, hk = unit & 3;
        const int kc0 = n >= 2 ? n - 2 : 0, nkeys = (n - kc0 + 1) * 64, nkt = nkeys >> 4;
        const int tq0 = b * SEQ + n * 64;
        __syncthreads();
#pragma unroll
        for (int i = 0; i < 4; ++i) { const int p = tid + 512 * i, r = p >> 3, pc = p & 7, g = r >> 6, qi = r & 63;
            *(LAS u32x4*)(Qs + r * 72 + pc * 8) = *(const GAS u32x4*)(PROJ + (size_t)(tq0 + qi) * PW + C_Q + (hk * 4 + g) * 64 + pc * 8); }
#pragma unroll
        for (int i = 0; i < 3; ++i) { const int p = tid + 512 * i;
            if (p < nkeys * 8) { const int r = p >> 3, pc = p & 7;
                *(LAS u32x4*)(Ks + r * 72 + pc * 8) = pk[i];
                const u32x4 vv = pv[i];
                LAS bf16_t* vp = Vt + (pc * 8) * 200 + r;
                vp[0] = (bf16_t)(vv.x & 0xffffu); vp[200] = (bf16_t)(vv.x >> 16); vp[400] = (bf16_t)(vv.y & 0xffffu); vp[600] = (bf16_t)(vv.y >> 16);
                vp[800] = (bf16_t)(vv.z & 0xffffu); vp[1000] = (bf16_t)(vv.z >> 16); vp[1200] = (bf16_t)(vv.w & 0xffffu); vp[1400] = (bf16_t)(vv.w >> 16); } }
        if (tid < 64 + nkeys) posl[tid] = ppos;
        if (unit_next < NB * 32 * 4) SWA_FETCH(unit_next);
        __syncthreads();
        if (tid < 256 + nkeys) {
            const bool isq = tid < 256;
            LAS bf16_t* rp = isq ? Qs + tid * 72 : Ks + (tid - 256) * 72;
            const LAS float* nw = nrm + (isq ? 0 : 64);
            unsigned xw[32];
#pragma unroll
            for (int i = 0; i < 8; ++i) { const u32x4 v = *(const LAS u32x4*)(rp + 8 * i); xw[4 * i] = v.x; xw[4 * i + 1] = v.y; xw[4 * i + 2] = v.z; xw[4 * i + 3] = v.w; }
            float ss = 0.f;
#pragma unroll
            for (int j = 0; j < 32; ++j) { const float a = bflo(xw[j]), b = bfhi(xw[j]); ss += a * a + b * b; }
            const float rstd = 1.0f / sqrtf(ss * (1.0f / 64.0f) + EPS);
            const float pf = (float)posl[isq ? (tid & 63) : (64 + tid - 256)];
#pragma unroll
            for (int j = 0; j < 16; ++j) {
                float o1[2], o2[2];
#pragma unroll
                for (int e = 0; e < 2; ++e) { const int i = 2 * j + e;
                    const float y1 = (e ? bfhi(xw[j]) : bflo(xw[j])) * rstd * nw[i], y2 = (e ? bfhi(xw[16 + j]) : bflo(xw[16 + j])) * rstd * nw[i + 32];
                    const float ang = pf * INV_FREQ[i];
                    double rev = (double)ang * 0.15915494309189535; rev -= __builtin_rint(rev);
                    const float fr_ = (float)rev, sn = __builtin_amdgcn_sinf(fr_), cs = __builtin_amdgcn_cosf(fr_);
                    o1[e] = y1 * cs - y2 * sn; o2[e] = y2 * cs + y1 * sn; }
                xw[j] = cvt_pk_bf16(o1[0], o1[1]); xw[16 + j] = cvt_pk_bf16(o2[0], o2[1]);
            }
#pragma unroll
            for (int i = 0; i < 8; ++i) { u32x4 v; v.x = xw[4 * i]; v.y = xw[4 * i + 1]; v.z = xw[4 * i + 2]; v.w = xw[4 * i + 3]; *(LAS u32x4*)(rp + 8 * i) = v; }
        }
        __syncthreads();
        const float sink = sinks[hk * 4 + (w >> 1)];
#pragma unroll
        for (int qt = 0; qt < 2; ++qt) {
            const int qrow = 32 * w + 16 * qt + fr;
            bf16x8 qf[2];
#pragma unroll
            for (int ks = 0; ks < 2; ++ks) qf[ks] = *(const LAS bf16x8*)(Qs + qrow * 72 + 32 * ks + 8 * kq);
            f32x4 s[12];
#pragma unroll
            for (int t = 0; t < 12; ++t) { s[t] = (f32x4){0.f, 0.f, 0.f, 0.f};
                if (t < nkt) {
#pragma unroll
                    for (int ks = 0; ks < 2; ++ks) { const bf16x8 a = *(const LAS bf16x8*)(Ks + (16 * t + fr) * 72 + 32 * ks + 8 * kq); s[t] = MFMA16(a, qf[ks], s[t]); } } }
            float mx = sink;
#pragma unroll
            for (int t = 0; t < 12; ++t) if (t < nkt) {
#pragma unroll
                for (int e = 0; e < 4; ++e) { s[t][e] *= 0.125f; mx = fmaxf(mx, s[t][e]); } }
            mx = fmaxf(mx, shx(mx, lane, 16)); mx = fmaxf(mx, shx(mx, lane, 32));
            float sum = 0.f;
#pragma unroll
            for (int t = 0; t < 12; ++t) if (t < nkt) {
#pragma unroll
                for (int e = 0; e < 4; ++e) { const float p = fexp(s[t][e] - mx); s[t][e] = p; sum += p; } }
            sum += shx(sum, lane, 16); sum += shx(sum, lane, 32);
            const float inv = 1.0f / (sum + fexp(sink - mx));
            f32x4 o[4];
#pragma unroll
            for (int dt = 0; dt < 4; ++dt) o[dt] = (f32x4){0.f, 0.f, 0.f, 0.f};
#pragma unroll
            for (int k2 = 0; k2 < 6; ++k2) if (2 * k2 < nkt) {
                u32x4 pk; pk.x = cvt_pk_bf16(s[2 * k2][0], s[2 * k2][1]); pk.y = cvt_pk_bf16(s[2 * k2][2], s[2 * k2][3]);
                pk.z = cvt_pk_bf16(s[2 * k2 + 1][0], s[2 * k2 + 1][1]); pk.w = cvt_pk_bf16(s[2 * k2 + 1][2], s[2 * k2 + 1][3]);
                const bf16x8 pf = __builtin_bit_cast(bf16x8, pk);
#pragma unroll
                for (int dt = 0; dt < 4; ++dt) {
                    const LAS bf16_t* vp = Vt + (16 * dt + fr) * 200 + 32 * k2 + 4 * kq;
                    const bf16x4 lo = *(const LAS bf16x4*)vp, hi = *(const LAS bf16x4*)(vp + 16);
                    const bf16x8 a = __builtin_shufflevector(lo, hi, 0, 1, 2, 3, 4, 5, 6, 7);
                    o[dt] = MFMA16(a, pf, o[dt]); } }
            const int g = qrow >> 6, qi = qrow & 63;
            GAS bf16_t* op = PROJ + (size_t)(tq0 + qi) * PW + C_Q + (hk * 4 + g) * 64 + 4 * kq;
#pragma unroll
            for (int dt = 0; dt < 4; ++dt) { u32x2 wv; wv.x = cvt_pk_bf16(o[dt][0] * inv, o[dt][1] * inv); wv.y = cvt_pk_bf16(o[dt][2] * inv, o[dt][3] * inv);
                *(GAS u32x2*)(op + 16 * dt) = wv; }
        }
        unit = unit_next;
    }
#undef SWA_FETCH
}

__device__ __forceinline__ void mlstm_phase(int wid_s, LAS unsigned char* lds, GAS bf16_t* PROJ, const GAS bf16_t* KM, const GAS float* IF, GAS float* SSQ) {
    const int tid = opaque_tid(wid_s), w = __builtin_amdgcn_readfirstlane(tid >> 6), lane = tid & 63, fr = lane & 15, kq = lane >> 4;
    LAS bf16_t* Qs = (LAS bf16_t*)lds;
    LAS bf16_t* Ks = Qs + 64 * 264;
    LAS bf16_t* Ct = Ks + 64 * 264;
    LAS bf16_t* Vt = Ct + 80 * 264;
    LAS bf16_t* Vw = Vt + 80 * 72;
    LAS bf16_t* Sw = Vw + 80 * 72;
    LAS float* vec = (LAS float*)(Sw + 64 * 72);
    const int tt = w & 3, wh = w >> 2, ndv = wh ? 2 : 3, dv0 = wh ? 3 : 0, nh = wh ? 1 : 3;
    for (int unit = row_cu(opaque_bx(), gridDim.x); unit < 256; unit += gridDim.x) {
        const int bh = unit >> 2, dvq = unit & 3, b = bh >> 2, h = bh & 3;
        __syncthreads();
        for (int i = tid; i < 80 * 264 / 2; i += 512) ((LAS unsigned*)Ct)[i] = 0u;
        for (int i = tid; i < 16 * 72; i += 512) { Vt[64 * 72 + i] = (i < 64) ? (bf16_t)0x3f80 : (bf16_t)0; Vw[64 * 72 + i] = 0; }
        f32x4 Cacc[2][5];
#pragma unroll
        for (int i = 0; i < 2; ++i)
#pragma unroll
            for (int j = 0; j < 5; ++j) Cacc[i][j] = (f32x4){0.f, 0.f, 0.f, 0.f};
        float m = 0.f;
        u32x4 nq[4], nk[4], nv; float nli, nlf;
        const unsigned voq = (unsigned)(((tid >> 5) * PW + (tid & 31) * 8) * 2), vok = (unsigned)(((tid >> 5) * DM + (tid & 31) * 8) * 2);
        const unsigned vov = (unsigned)(((tid >> 3) * PW + (tid & 7) * 8) * 2), voi = (unsigned)lane * 32u;
#define MLSTM_FETCH(t1) do { \
          const GAS char* qb_ = (const GAS char*)(PROJ + (size_t)(t1) * PW + C_U + h * 256); const GAS char* kb_ = (const GAS char*)(KM + (size_t)(t1) * DM + h * 256); \
          const GAS char* vb_ = (const GAS char*)(PROJ + (size_t)(t1) * PW + C_V + h * 256 + dvq * 64); const GAS char* ib_ = (const GAS char*)(IF + (size_t)(t1) * 8 + h); \
          nli = *(const GAS float*)(ib_ + voi); nlf = *(const GAS float*)(ib_ + 16 + voi); \
          _Pragma("unroll") for (int i = 0; i < 4; ++i) { nq[i] = *(const GAS u32x4*)(qb_ + (size_t)i * 16 * PW * 2 + voq); nk[i] = *(const GAS u32x4*)(kb_ + (size_t)i * 16 * DM * 2 + vok); } \
          nv = *(const GAS u32x4*)(vb_ + vov); } while (0)
        MLSTM_FETCH(b * SEQ);
        f32x4 num[3];
#define MLSTM_OUT(t_out, vc_out) do { \
                const f32x4 den4 = *(const LAS f32x4*)((vc_out) + 192 + 16 * tt + 4 * kq), b4 = *(const LAS f32x4*)((vc_out) + 128 + 16 * tt + 4 * kq), Mo4 = *(const LAS f32x4*)((vc_out) + 64 + 16 * tt + 4 * kq); \
                float dd[4], ss[4]; \
                _Pragma("unroll") for (int e = 0; e < 4; ++e) { dd[e] = 1.0f / fmaxf(fabsf(den4[e]), fexp(-(b4[e] + Mo4[e]))); ss[e] = 0.f; } \
                _Pragma("unroll") for (int j = 0; j < 3; ++j) if (j < nh) { \
                    _Pragma("unroll") for (int e = 0; e < 4; ++e) { const float hv = num[j][e] * dd[e]; ss[e] += hv * hv; \
                        PROJ[(size_t)((t_out) + 16 * tt + 4 * kq + e) * PW + C_V + h * 256 + dvq * 64 + 16 * (dv0 + j) + fr] = f2bf(hv); } } \
                _Pragma("unroll") for (int e = 0; e < 4; ++e) { float v = ss[e]; \
                    v += DPP_F(v, v, 0x128, 0xf); v += DPP_F(v, v, 0x124, 0xf); v += DPP_F(v, v, 0x122, 0xf); v += DPP_F(v, v, 0x121, 0xf); \
                    if (fr == 0) __hip_atomic_fetch_add(SSQ + (size_t)((t_out) + 16 * tt + 4 * kq + e) * 4 + h, v, __ATOMIC_RELAXED, __HIP_MEMORY_SCOPE_AGENT); } } while (0)
#pragma unroll 1
        for (int c = 0; c < 32; ++c) {
            const int t0 = b * SEQ + c * 64;
            LAS float* vc = vec + (c & 1) * 256;
            const float li = nli, lf = nlf;
            const float bcs = scan_sum64(lf);
            const float uu = li - bcs;
            const float cm = scan_max64(uu);
            const float Mv = fmaxf(m, cm);
            const float b63 = __int_as_float(__builtin_amdgcn_readlane(__float_as_int(bcs), 63)), cm63 = __int_as_float(__builtin_amdgcn_readlane(__float_as_int(cm), 63)), Mend = fmaxf(m, cm63);
            const float wg = fexp(uu - Mend), decay = fexp(m - Mend), m_old = m;
            m = b63 + Mend;
            if (w == 0) { vc[lane] = uu; vc[64 + lane] = Mv; vc[128 + lane] = bcs; Vw[64 * 72 + lane] = f2bf(wg); }
#pragma unroll
            for (int i = 0; i < 4; ++i) { const int p = tid + 512 * i, r = p >> 5, pc = p & 31;
                *(LAS u32x4*)(Qs + r * 264 + pc * 8) = nq[i];
                *(LAS u32x4*)(Ks + r * 264 + pc * 8) = nk[i]; }
            { const int r = tid >> 3, pc = tid & 7;
              const float wgr = shi(wg, r & 63);
              const unsigned vs[4] = {nv.x, nv.y, nv.z, nv.w};
#pragma unroll
              for (int e = 0; e < 4; ++e) { const int d = pc * 8 + 2 * e;
                  Vt[d * 72 + r] = (bf16_t)(vs[e] & 0xffffu); Vt[(d + 1) * 72 + r] = (bf16_t)(vs[e] >> 16);
                  Vw[d * 72 + r] = f2bf(bflo(vs[e]) * wgr); Vw[(d + 1) * 72 + r] = f2bf(bfhi(vs[e]) * wgr); } }
            if (c + 1 < 32) MLSTM_FETCH(t0 + 64);
            if (c > 0) MLSTM_OUT(t0 - 64, vec + ((c - 1) & 1) * 256);
            __syncthreads();
            bf16x8 qfr[8];
#pragma unroll
            for (int ks = 0; ks < 8; ++ks) qfr[ks] = *(const LAS bf16x8*)(Qs + (16 * tt + fr) * 264 + 32 * ks + 8 * kq);
            {
                const int t = 16 * tt + fr; const float Mt = vc[64 + t];
#pragma unroll
                for (int si = 0; si < 2; ++si) { const int st = 2 * wh + si; f32x4 sa = (f32x4){0.f, 0.f, 0.f, 0.f};
                    if (st <= tt) {
#pragma unroll
                        for (int ks = 0; ks < 8; ++ks) { const bf16x8 a = *(const LAS bf16x8*)(Ks + (16 * st + fr) * 264 + 32 * ks + 8 * kq); sa = MFMA16(a, qfr[ks], sa); } }
                    const f32x4 u4 = *(const LAS f32x4*)(vc + 16 * st + 4 * kq);
#pragma unroll
                    for (int e = 0; e < 4; ++e) { const int s = 16 * st + 4 * kq + e; const float wgt = (s <= t) ? fexp(u4[e] - Mt) : 0.f; sa[e] *= wgt; }
                    u32x2 pk; pk.x = cvt_pk_bf16(sa[0], sa[1]); pk.y = cvt_pk_bf16(sa[2], sa[3]);
                    *(LAS u32x2*)(Sw + t * 72 + 16 * st + 4 * kq) = pk; }
            }
#pragma unroll
            for (int j = 0; j < 3; ++j) num[j] = (f32x4){0.f, 0.f, 0.f, 0.f};
#pragma unroll
            for (int ks = 0; ks < 8; ++ks) { const bf16x8 aq = qfr[ks];
#pragma unroll
                for (int j = 0; j < 3; ++j) if (j < ndv) { const bf16x8 bc = *(const LAS bf16x8*)(Ct + (16 * (dv0 + j) + fr) * 264 + 32 * ks + 8 * kq); num[j] = MFMA16(aq, bc, num[j]); } }
            const f32x4 M4 = *(const LAS f32x4*)(vc + 64 + 16 * tt + 4 * kq);
#pragma unroll
            for (int e = 0; e < 4; ++e) { const float wi = fexp(m_old - M4[e]);
#pragma unroll
                for (int j = 0; j < 3; ++j) num[j][e] *= wi; }
            __syncthreads();
#pragma unroll
            for (int ks = 0; ks < 2; ++ks) { const bf16x8 as = *(const LAS bf16x8*)(Sw + (16 * tt + fr) * 72 + 32 * ks + 8 * kq);
#pragma unroll
                for (int j = 0; j < 3; ++j) if (j < ndv) { const bf16x8 bv = *(const LAS bf16x8*)(Vt + (16 * (dv0 + j) + fr) * 72 + 32 * ks + 8 * kq); num[j] = MFMA16(as, bv, num[j]); } }
#pragma unroll
            for (int i = 0; i < 2; ++i)
#pragma unroll
                for (int j = 0; j < 5; ++j) Cacc[i][j] *= decay;
#pragma unroll
            for (int ks = 0; ks < 2; ++ks) {
                bf16x8 ak[2];
#pragma unroll
                for (int i = 0; i < 2; ++i) { const LAS bf16_t* kp = Ks + (32 * ks + 8 * kq) * 264 + 16 * (2 * w + i) + fr;
#pragma unroll
                    for (int e = 0; e < 8; ++e) ak[i][e] = (short)kp[e * 264]; }
#pragma unroll
                for (int j = 0; j < 5; ++j) { const bf16x8 bv = *(const LAS bf16x8*)(Vw + (16 * j + fr) * 72 + 32 * ks + 8 * kq);
#pragma unroll
                    for (int i = 0; i < 2; ++i) Cacc[i][j] = MFMA16(ak[i], bv, Cacc[i][j]); } }
            if (wh == 1 && fr == 0) *(LAS f32x4*)(vc + 192 + 16 * tt + 4 * kq) = num[1];
#pragma unroll
            for (int i = 0; i < 2; ++i)
#pragma unroll
                for (int j = 0; j < 5; ++j) { u32x2 pk; pk.x = cvt_pk_bf16(Cacc[i][j][0], Cacc[i][j][1]); pk.y = cvt_pk_bf16(Cacc[i][j][2], Cacc[i][j][3]);
                    *(LAS u32x2*)(Ct + (16 * j + fr) * 264 + 16 * (2 * w + i) + 4 * kq) = pk; }
            __syncthreads();
        }
        MLSTM_OUT(b * SEQ + 31 * 64, vec + 256);
    }
#undef MLSTM_OUT
}

__device__ __forceinline__ void fixup_phase(int wid_s, GAS bf16_t* PROJ, const GAS bf16_t* UA, const GAS float* SSQ, const GAS float* onorm, const GAS float* skip) {
    const int tid = opaque_tid(wid_s), cg8 = (tid & 127) * 8, rg = tid >> 7, hd = cg8 >> 8;
    float on[8], sk[8];
#pragma unroll
    for (int e = 0; e < 8; ++e) { on[e] = onorm[cg8 + e]; sk[e] = skip[cg8 + e]; }
    const int G_ = gridDim.x, rc_ = row_cu(opaque_bx(), G_), per_ = (G_ == 256) ? 2 : 1;
    for (int it_ = rc_ * per_; it_ < T / 64; it_ += (it_ % per_ == per_ - 1) ? (G_ * per_ - (per_ - 1)) : 1) {
        const int item = it_;
#pragma unroll 4
        for (int rr = 0; rr < 16; ++rr) {
            const size_t row = (size_t)item * 64 + rg * 16 + rr;
            const u32x4 hv = *(const GAS u32x4*)(PROJ + row * PW + C_V + cg8), ov = *(const GAS u32x4*)(PROJ + row * PW + C_O + cg8), uv = *(const GAS u32x4*)(UA + row * DM + cg8);
            const float rstd = 1.0f / sqrtf(SSQ[row * 4 + hd] * (1.0f / 256.0f) + EPS);
            const float hh[8] = {bflo(hv.x), bfhi(hv.x), bflo(hv.y), bfhi(hv.y), bflo(hv.z), bfhi(hv.z), bflo(hv.w), bfhi(hv.w)};
            const float oo[8] = {bflo(ov.x), bfhi(ov.x), bflo(ov.y), bfhi(ov.y), bflo(ov.z), bfhi(ov.z), bflo(ov.w), bfhi(ov.w)};
            const float ua[8] = {bflo(uv.x), bfhi(uv.x), bflo(uv.y), bfhi(uv.y), bflo(uv.z), bfhi(uv.z), bflo(uv.w), bfhi(uv.w)};
            float y[8];
#pragma unroll
            for (int e = 0; e < 8; ++e) y[e] = fsigmoid(oo[e]) * (hh[e] * rstd * on[e] + sk[e] * ua[e]);
            u32x4 wv; wv.x = cvt_pk_bf16(y[0], y[1]); wv.y = cvt_pk_bf16(y[2], y[3]); wv.z = cvt_pk_bf16(y[4], y[5]); wv.w = cvt_pk_bf16(y[6], y[7]);
            *(GAS u32x4*)(PROJ + row * PW + C_O + cg8) = wv;
        }
    }
}


#define XB_TMO      128
#define XB_XCNT(j)  (256  + 64 * (j))
#define XB_XSUB(j)  (1280 + 64 * (j))
#define XB_XGEN(j)  (2304 + 64 * (j))
#define XB_TOP      3328
#define XB_TOPGEN   3392
#define XCD_BAR_WORDS 3456
#define XB_SPIN_CAP (1u << 19)
__device__ __forceinline__ unsigned xb_ld(GAS unsigned* p)              { return __hip_atomic_load(p, __ATOMIC_RELAXED, __HIP_MEMORY_SCOPE_AGENT); }
__device__ __forceinline__ unsigned xb_add(GAS unsigned* p, unsigned v) { return __hip_atomic_fetch_add(p, v, __ATOMIC_RELAXED, __HIP_MEMORY_SCOPE_AGENT); }
__device__ __forceinline__ unsigned xb_xcc_id() { return (unsigned)__builtin_amdgcn_s_getreg((3 << 11) | 20) & 0xFu; }
#define XB_SPIN(cond, bar) do { unsigned _sp = 0; while (cond) { __builtin_amdgcn_s_sleep(1); \
    if ((++_sp & 255u) == 0u) { if (xb_ld(&(bar)[XB_TMO])) break; if (_sp > XB_SPIN_CAP) { xb_add(&(bar)[XB_TMO], 1u); break; } } } } while (0)
__device__ __forceinline__ void xcd_barrier_complete(GAS unsigned* bar, unsigned x, unsigned& nloc, unsigned& nx) {
    const unsigned G = gridDim.x;
    unsigned sum, cnt, mine, sp = 0u;
    for (;;) {
        sum = 0u; cnt = 0u; mine = 0u;
#pragma unroll
        for (unsigned j = 0; j < 16; ++j) { const unsigned c = xb_ld(&bar[XB_XCNT(j)]); sum += c; cnt += (c > 0u) ? 1u : 0u; mine = (j == x) ? c : mine; }
        if (sum == G) break;
        __builtin_amdgcn_s_sleep(1);
        if ((++sp & 255u) == 0u) { if (xb_ld(&bar[XB_TMO])) break; if (sp > XB_SPIN_CAP) { xb_add(&bar[XB_TMO], 1u); break; } }
    }
    nloc = mine > 0u ? mine : 1u; nx = cnt > 0u ? cnt : 1u;
}
__device__ __forceinline__ void grid_barrier(int wid_s, GAS unsigned* bar, volatile LAS unsigned* st) {
    const int tid = opaque_tid(wid_s);
    asm volatile("s_waitcnt vmcnt(0)" ::: "memory");
    __syncthreads();
    if (tid == 0) {
        __builtin_amdgcn_s_waitcnt(0);
        const unsigned x = xb_xcc_id();
        unsigned nloc = st[0], nx = st[1];
        if (nloc == 0u) { xcd_barrier_complete(bar, x, nloc, nx); st[0] = nloc; st[1] = nx; }
        const unsigned old = xb_add(&bar[XB_XSUB(x)], 1u);
        const unsigned gen = old / nloc;
        if (old + 1u == (gen + 1u) * nloc) {
            __builtin_amdgcn_fence(__ATOMIC_RELEASE, "agent");
            asm volatile("s_waitcnt vmcnt(0)" ::: "memory");
            const unsigned og = xb_add(&bar[XB_TOP], 1u);
            const unsigned tg = og / nx;
            if (og + 1u == (tg + 1u) * nx) xb_add(&bar[XB_TOPGEN], 1u);
            else XB_SPIN(xb_ld(&bar[XB_TOPGEN]) == tg, bar);
            __builtin_amdgcn_fence(__ATOMIC_ACQUIRE, "agent");
            xb_add(&bar[XB_XGEN(x)], 1u);
            asm volatile("s_waitcnt vmcnt(0)" ::: "memory");
        } else {
            XB_SPIN(xb_ld(&bar[XB_XGEN(x)]) == gen, bar);
            __builtin_amdgcn_fence(__ATOMIC_ACQUIRE, "agent");
            asm volatile("s_waitcnt vmcnt(0)" ::: "memory");
        }
    }
    __syncthreads();
}

#define XL_CNT(j) (3520 + 64 * (j))
#define XL_WORDS 4608
__device__ __forceinline__ void xcd_local_barrier(int wid_s, GAS unsigned* bar, volatile LAS unsigned* st) {
    const int tid = opaque_tid(wid_s);
    asm volatile("s_waitcnt vmcnt(0)" ::: "memory");
    __syncthreads();
    if (tid == 0) {
        const unsigned x = xb_xcc_id(), nloc = st[0];
        const unsigned old = xb_add(&bar[XL_CNT(x)], 1u), target = (old / nloc + 1u) * nloc;
        { unsigned sp_ = 0; while (xb_ld(&bar[XL_CNT(x)]) < target) { if ((++sp_ & 4095u) == 0u) { if (xb_ld(&bar[XB_TMO])) break; if (sp_ > (1u << 24)) { xb_add(&bar[XB_TMO], 1u); break; } } } }
        __builtin_amdgcn_fence(__ATOMIC_ACQUIRE, "agent");
        asm volatile("s_waitcnt vmcnt(0)" ::: "memory");
    }
    __syncthreads();
}

typedef const __attribute__((address_space(4))) unsigned long long* kargp_t;
__device__ __forceinline__ unsigned long long ldarg(int i) { kargp_t kp = (kargp_t)__builtin_amdgcn_kernarg_segment_ptr(); asm volatile("" : "+s"(kp)); return kp[i]; }
#define PIN(i) ((const GAS float*)ldarg(i))
#define POUT ((GAS float*)ldarg(28))
#define WSP(off) ((GAS unsigned char*)ldarg(29) + (off))
#define WB(off) ((GAS bf16_t*)(((sidx & 1) ? WSP(WS_W) : ((GAS unsigned char*)ldarg(28) + 64 * MiB)) + (off)))
#define MODL(l) ((const GAS float*)WSP(WS_MOD) + (size_t)(l) * NB * 9216)

__global__ void __launch_bounds__(512, 2) mega_fwd(Params p) {
    extern __shared__ __attribute__((aligned(16))) unsigned char lds_raw[];
    LAS unsigned char* lds = (LAS unsigned char*)lds_raw;
    const int wid_s = __builtin_amdgcn_readfirstlane((int)(threadIdx.x >> 6));
    volatile LAS unsigned* bst = (volatile LAS unsigned*)(lds + LDS_BYTES - 16);
    { GAS unsigned* bar = (GAS unsigned*)WSP(0);
      if (threadIdx.x == 0) { *(volatile LAS int*)VBX_LDS_ADDR = (int)blockIdx.x; bst[0] = 0u; bst[1] = 0u; }
      if (blockIdx.x == 0) for (int i = threadIdx.x; i < XL_WORDS; i += 512) __hip_atomic_store(bar + i, 0u, __ATOMIC_RELAXED, __HIP_MEMORY_SCOPE_AGENT);
      __syncthreads();
      mod_phase(wid_s, lds, PIN(I_C), PIN(I_ADAW), PIN(I_ADAB), (GAS float*)WSP(WS_MOD));
      cg::this_grid().sync();
      const unsigned xcc = xb_xcc_id(); unsigned rank = 0u;
      if (threadIdx.x == 0) rank = xb_add(bar + XB_XCNT(xcc & 15u), 1u);
      grid_barrier(wid_s, bar, bst);
      if (threadIdx.x == 0) {
          bool ok = (gridDim.x == 256) && (xcc < 8u);
          for (int j = 0; j < 16; ++j) ok = ok && (xb_ld(bar + XB_XCNT(j)) == (j < 8 ? 32u : 0u));
          if (ok) *(volatile LAS int*)VBX_LDS_ADDR = (int)(xcc + 8u * rank);
          *(volatile LAS int*)(VBX_LDS_ADDR + 4u) = ok ? 1 : 0;
      }
      __syncthreads(); }
#define GRID_SYNC() grid_barrier(wid_s, (GAS unsigned*)WSP(0), bst)
#define XCD_SYNC() do { if (__builtin_amdgcn_readfirstlane(*(volatile LAS int*)(VBX_LDS_ADDR + 4u))) xcd_local_barrier(wid_s, (GAS unsigned*)WSP(0), bst); else grid_barrier(wid_s, (GAS unsigned*)WSP(0), bst); } while (0)

#pragma unroll 1
    for (int l = 0; l < 2; ++l) {
#pragma unroll 1
        for (int stage = 0; stage < 3; ++stage) {
            const int G = gridDim.x, bx = opaque_bx();
            const int sidx = l * 3 + stage;
            if (stage != 1) {
                const int f = stage >> 1;
                {
                    const int tid = opaque_tid(wid_s), wv = tid >> 6, lane = tid & 63, gw = bx * 8 + wv, NGW = G * 8;
                    LAS float* cscr = (LAS float*)(lds + 32768 + wv * 8448);
                    const bool first = (l == 0 && stage == 0), last = (l == 1 && stage == 2);
                    const GAS void* xin = first ? (const GAS void*)PIN(I_X) : (const GAS void*)POUT;
                    modulate_phase<false>(wid_s, lds, xin, first ? 1 : 0, last ? (GAS bf16_t*)WSP(WS_UA) : (GAS bf16_t*)nullptr, PIN(f ? I_F2N : I_F1N) + l * DM, MODL(l), f ? 6 : 0, (GAS bf16_t*)WSP(WS_H), nullptr, nullptr, nullptr, nullptr);
                    int base = 0;
                    CvtJob j1{PIN(f ? I_F2WI : I_F1WI) + (size_t)l * DM * 2 * FF, 2 * FF, DM, 2 * FF, WB(W_F1), 2, 1.0f}; cvt_run(j1, base, gw, NGW, cscr, lane);
                    CvtJob j2{PIN(f ? I_F2WO : I_F1WO) + (size_t)l * FF * DM, DM, FF, DM, WB(W_F2), 0, 1.0f}; cvt_run(j2, base, gw, NGW, cscr, lane);
                }
                GRID_SYNC();
                { pg8::Gemm g{(GAS bf16_t*)WSP(WS_H), WB(W_F1), T, 2 * FF, DM, DM, DM, 1 << 30, 0}; pg8::StaticOrder S; S.init(T, 2 * FF, G, bx);
                  pg8::EpiSwiGLU E{(GAS bf16_t*)WSP(WS_PROJ), FF}; pg8::gemm_phase(wid_s, lds, g, S, E); }
                XCD_SYNC();
                { pg8::Gemm g{(GAS bf16_t*)WSP(WS_PROJ), WB(W_F2), T, DM, FF, FF, FF, 1 << 30, 0}; pg8::StaticOrder S; S.init(T, DM, G, bx);
                  const bool first = (l == 0 && stage == 0), last = (l == 1 && stage == 2);
                  const GAS void* xin = first ? (const GAS void*)PIN(I_X) : (last ? (const GAS void*)WSP(WS_UA) : (const GAS void*)POUT);
                  pg8::EpiRes E{xin, (GAS void*)POUT, MODL(l) + (f ? 8 : 2) * 1024, 9216, 0.5f, first ? 1 : 0, last ? 1 : 0}; pg8::gemm_phase(wid_s, lds, g, S, E); }
                XCD_SYNC();
            } else {
                {
                    const int tid = opaque_tid(wid_s), wv = tid >> 6, lane = tid & 63, gw = bx * 8 + wv, NGW = G * 8;
                    LAS float* cscr = (LAS float*)(lds + 32768 + wv * 8448);
                    const GAS float* mixw = PIN(I_MIXW) + (size_t)l * DM * NIN;
                    modulate_phase<true>(wid_s, lds, (const GAS void*)POUT, 0, (GAS bf16_t*)nullptr, PIN(I_MIXN) + l * DM, MODL(l), 3, (GAS bf16_t*)WSP(WS_H), mixw, PIN(I_GATEB) + l * 8, (GAS float*)WSP(WS_IF), (GAS float*)WSP(WS_SSQ));
                    int base = 0;
                    CvtJob j1{mixw, NIN, DM, PW, WB(W_MIX), 1, 1.0f}; cvt_run(j1, base, gw, NGW, cscr, lane);
                    CvtJob j2{PIN(I_MERGEW) + (size_t)l * DM * 2 * DM, 2 * DM, DM, 2 * DM, WB(W_MERGE), 0, -1.4426950408889634f}; cvt_run(j2, base, gw, NGW, cscr, lane);
                    CvtJob j3{PIN(I_PA) + (size_t)l * DM * DM, DM, DM, DM, WB(W_PA), 0, 1.0f}; cvt_run(j3, base, gw, NGW, cscr, lane);
                    CvtJob j4{PIN(I_PB) + (size_t)l * DM * DM, DM, DM, DM, WB(W_PB), 0, 1.0f}; cvt_run(j4, base, gw, NGW, cscr, lane);
                    CvtJob j5{PIN(I_WOUT) + (size_t)l * DM * DM, DM, DM, DM, WB(W_WO), 0, 1.0f}; cvt_run(j5, base, gw, NGW, cscr, lane);
#pragma unroll 1
                    for (int hd = 0; hd < 4; ++hd) {
                        CvtJob jq{PIN(I_WQ) + ((size_t)l * 4 + hd) * 65536, 256, 256, 256, WB(W_QK) + (size_t)hd * 512 * 256, 0, 1.0f}; cvt_run(jq, base, gw, NGW, cscr, lane);
                        CvtJob jk{PIN(I_WK) + ((size_t)l * 4 + hd) * 65536, 256, 256, 256, WB(W_QK) + (size_t)hd * 512 * 256 + 256 * 256, 0, 0.0625f}; cvt_run(jk, base, gw, NGW, cscr, lane);
                    }
                }
                GRID_SYNC();
                { pg8::Gemm g{(GAS bf16_t*)WSP(WS_H), WB(W_MIX), T, PW, DM, DM, DM, 1 << 30, 0}; pg8::StaticOrder S; S.init(T, PW, G, bx);
                  GAS bf16_t* PROJ = (GAS bf16_t*)WSP(WS_PROJ);
                  pg8::EpiStore2 E{PROJ, PW, PROJ, PW, 1 << 30, nullptr, 0}; pg8::gemm_phase(wid_s, lds, g, S, E); }
                XCD_SYNC();
                conv_phase(wid_s, (GAS bf16_t*)WSP(WS_PROJ), PIN(I_CONVW) + l * 4 * DM, PIN(I_CONVB) + l * DM, (GAS bf16_t*)WSP(WS_UA));
                swa_phase(wid_s, lds, (GAS bf16_t*)WSP(WS_PROJ), (const GAS int*)PIN(I_POS), PIN(I_QN) + l * 64, PIN(I_KN) + l * 64, PIN(I_SINK) + l * 16);
                XCD_SYNC();
                { pg8::Gemm g{(GAS bf16_t*)WSP(WS_UA), WB(W_QK), T, 2048, 256, DM, 256, 2, 512}; pg8::StaticOrder S; S.init(T, 2048, G, bx);
                  pg8::EpiQK E{(GAS bf16_t*)WSP(WS_PROJ) + C_U, PW, (GAS bf16_t*)WSP(WS_KM), DM}; pg8::gemm_phase(wid_s, lds, g, S, E); }
                XCD_SYNC();
                mlstm_phase(wid_s, lds, (GAS bf16_t*)WSP(WS_PROJ), (GAS bf16_t*)WSP(WS_KM), (const GAS float*)WSP(WS_IF), (GAS float*)WSP(WS_SSQ));
                XCD_SYNC();
                fixup_phase(wid_s, (GAS bf16_t*)WSP(WS_PROJ), (GAS bf16_t*)WSP(WS_UA), (const GAS float*)WSP(WS_SSQ), PIN(I_ONORM) + l * DM, PIN(I_SKIP) + l * DM);
                { pg8::Gemm g{(GAS bf16_t*)WSP(WS_H), WB(W_MERGE), T, 2 * DM, DM, DM, DM, 1 << 30, 0}; pg8::StaticOrder S; S.init(T, 2 * DM, G, bx);
                  pg8::EpiStore2 E{(GAS bf16_t*)WSP(WS_PROJ) + C_U, PW, (GAS bf16_t*)WSP(WS_KM), DM, 4, PIN(I_MERGEB) + l * 2 * DM, 1}; pg8::gemm_phase(wid_s, lds, g, S, E); }
                XCD_SYNC();
                { pg8::Gemm g{(GAS bf16_t*)WSP(WS_PROJ) + C_O, WB(W_PA), T, DM, DM, PW, DM, 1 << 30, 0}; pg8::StaticOrder S; S.init(T, DM, G, bx);
                  pg8::EpiGate<0> E{(GAS bf16_t*)WSP(WS_H), DM, (GAS bf16_t*)WSP(WS_PROJ) + C_U, PW}; pg8::gemm_phase(wid_s, lds, g, S, E); }
                { pg8::Gemm g{(GAS bf16_t*)WSP(WS_PROJ) + C_Q, WB(W_PB), T, DM, DM, PW, DM, 1 << 30, 0}; pg8::StaticOrder S; S.init(T, DM, G, bx);
                  pg8::EpiGate<1> E{(GAS bf16_t*)WSP(WS_H), DM, (GAS bf16_t*)WSP(WS_KM), DM}; pg8::gemm_phase(wid_s, lds, g, S, E); }
                XCD_SYNC();
                { pg8::Gemm g{(GAS bf16_t*)WSP(WS_H), WB(W_WO), T, DM, DM, DM, DM, 1 << 30, 0}; pg8::StaticOrder S; S.init(T, DM, G, bx);
                  pg8::EpiRes E{(const GAS void*)POUT, (GAS void*)POUT, MODL(l) + 5 * 1024, 9216, 1.0f, 0, 0}; pg8::gemm_phase(wid_s, lds, g, S, E); }
                XCD_SYNC();
            }
            if (l == STOP_L && stage == STOP_STAGE) return;
        }
    }
}

extern "C" void kernel_launch(void* const* d_in, const int* in_sizes, int n_in, void* d_out, int out_size, void* d_ws, size_t ws_size, hipStream_t stream) {
    static int grid = 0;
    if (grid == 0) {
        if (n_in != 28 || out_size != T * DM || ws_size < WS_END) { fprintf(stderr, "kernel_launch: unexpected problem (n_in %d, out %d, ws %zu)\n", n_in, out_size, ws_size); grid = -1; return; }
        int dev = 0, cus = 0, per_cu = 0;
        hipGetDevice(&dev);
        hipDeviceGetAttribute(&cus, hipDeviceAttributeMultiprocessorCount, dev);
        hipFuncSetAttribute((const void*)mega_fwd, hipFuncAttributeMaxDynamicSharedMemorySize, LDS_BYTES);
        if (hipOccupancyMaxActiveBlocksPerMultiprocessor(&per_cu, (const void*)mega_fwd, 512, LDS_BYTES) != hipSuccess || per_cu < 1) per_cu = 1;
        (void)hipGetLastError();
        grid = cus * per_cu;
        if (grid < 1) grid = 256;
    }
    if (grid < 0) return;
    Params p{};
    for (int i = 0; i < 28; ++i) p.in[i] = (const float*)d_in[i];
    p.out = (float*)d_out; p.ws = (unsigned char*)d_ws;
    void* args[] = {&p};
    hipError_t e = hipLaunchCooperativeKernel((const void*)mega_fwd, dim3(grid), dim3(512), args, LDS_BYTES, stream);
    if (e != hipSuccess) fprintf(stderr, "cooperative launch failed: %s (grid %d)\n", hipGetErrorString(e), grid);
}
```
